# Optimizing an MI355X kernel written in HIP

```python
import math
import jax, jax.numpy as jnp
from jax import lax
import numpy as np

D_MODEL = 1024
BATCH = 8
SEQ = 4096
DEPTH = 4

HEAD_DIM = 64
LRU_WIDTH = D_MODEL // 2
LRU_BLOCKS = LRU_WIDTH // HEAD_DIM
LRU_CONV = 4
LRU_C = 8.0
LRU_MIN_RAD = 0.9
LRU_MAX_RAD = 0.999
FOX_HEADS = (D_MODEL // 2) // HEAD_DIM
FOX_DIM = FOX_HEADS * HEAD_DIM
SWA_HEADS = (D_MODEL // 2) // HEAD_DIM
SWA_KV_HEADS = max(1, SWA_HEADS // 4)
SWA_DIM = SWA_HEADS * HEAD_DIM
SWA_WINDOW = 128
S5_WIDTH = D_MODEL // 2
S5_GROUP = 16
S5_GROUPS = S5_WIDTH // S5_GROUP
S5_STATE = 64
D_FF = 256 * ((8 * D_MODEL // 3 + 255) // 256)
PLE_DIM = 256
ROPE_THETA = 10000.0
QBLOCK = 128
EPS = 1e-6
MACARON = 0.5
OUT_SCALE = 0.5
N_EVEN = (DEPTH + 1) // 2
N_ODD = DEPTH // 2
EV_IN = 2 * LRU_WIDTH + 3 * FOX_DIM + FOX_HEADS
OD_IN = SWA_DIM + 2 * SWA_KV_HEADS * HEAD_DIM + S5_WIDTH
MIX_WIDTH = LRU_WIDTH + FOX_DIM

kernel_name = "hybrid_rglru_fox_swa_s5_macaron"


def rms_norm(x, g):
    x32 = x.astype(jnp.float32)
    y = x32 * lax.rsqrt(jnp.mean(x32 * x32, axis=-1, keepdims=True) + EPS)
    return (y * g.astype(jnp.float32)).astype(x.dtype)


def swiglu(x, wg, wu, wd):
    return (jax.nn.silu(x @ wg) * (x @ wu)) @ wd


def rope(x, pos):
    half = x.shape[-1] // 2
    inv = jnp.power(ROPE_THETA, -jnp.arange(half, dtype=jnp.float32) / half)
    ang = pos.astype(jnp.float32)[:, None] * inv[None, :]
    cos = jnp.cos(ang)[None, :, None, :]
    sin = jnp.sin(ang)[None, :, None, :]
    x32 = x.astype(jnp.float32)
    x1, x2 = x32[..., :half], x32[..., half:]
    return jnp.concatenate([x1 * cos - x2 * sin, x2 * cos + x1 * sin], axis=-1).astype(x.dtype)


def linear_scan_combine(left, right):
    a1, b1 = left
    a2, b2 = right
    return a1 * a2, a2 * b1 + b2


def rg_lru(xa, conv_w, conv_b, wa, ba, wx, bx, lam):
    B_, S_, W = xa.shape
    xp = jnp.pad(xa, ((0, 0), (LRU_CONV - 1, 0), (0, 0)))
    xc = conv_b
    for tap in range(LRU_CONV):
        xc = xc + xp[:, tap:tap + S_] * conv_w[tap]
    xh = xc.reshape(B_, S_, LRU_BLOCKS, W // LRU_BLOCKS)
    r = jax.nn.sigmoid((jnp.einsum('bshi,hij->bshj', xh, wa).reshape(B_, S_, W) + ba).astype(jnp.float32))
    i = jax.nn.sigmoid((jnp.einsum('bshi,hij->bshj', xh, wx).reshape(B_, S_, W) + bx).astype(jnp.float32))
    log_a = -LRU_C * r * jax.nn.softplus(lam.astype(jnp.float32))
    a = jnp.exp(log_a)
    b = jnp.sqrt(-jnp.expm1(2.0 * log_a)) * (i * xc.astype(jnp.float32))
    _, h = lax.associative_scan(linear_scan_combine, (a, b), axis=1)
    return h.astype(xa.dtype)


def fox_attention(q, k, v, f_logit, b_f, qn, kn):
    B_, S_, H, Dh = q.shape
    q = rms_norm(q, qn)
    k = rms_norm(k, kn)
    log_f = jax.nn.log_sigmoid(f_logit.astype(jnp.float32) + b_f.astype(jnp.float32))
    c = jnp.cumsum(log_f, axis=1).transpose(0, 2, 1)
    nb = S_ // QBLOCK
    qb = q.transpose(0, 2, 1, 3).reshape(B_, H, nb, QBLOCK, Dh).transpose(2, 0, 1, 3, 4)
    cb = c.reshape(B_, H, nb, QBLOCK).transpose(2, 0, 1, 3)
    kh = k.transpose(0, 2, 1, 3)
    vh = v.transpose(0, 2, 1, 3)
    kpos = jnp.arange(S_)
    scale = Dh ** -0.5

    def block(args):
        qi, ci, n = args
        s = jnp.einsum('bhqd,bhkd->bhqk', qi, kh).astype(jnp.float32) * scale
        s = s + ci[..., None] - c[:, :, None, :]
        qpos = n * QBLOCK + jnp.arange(QBLOCK)
        mask = kpos[None, :] <= qpos[:, None]
        s = jnp.where(mask, s, -jnp.inf)
        pr = jax.nn.softmax(s, axis=-1)
        return jnp.einsum('bhqk,bhkd->bhqd', pr.astype(vh.dtype), vh)

    o = lax.map(block, (qb, cb, jnp.arange(nb)))
    return o.transpose(1, 0, 3, 2, 4).reshape(B_, S_, H * Dh)


def swa_sink_attention(q, k, v, sinks, qn, kn):
    B_, S_, H, Dh = q.shape
    KVH = k.shape[2]
    G = H // KVH
    W = SWA_WINDOW
    nb = S_ // W
    pos = jnp.arange(S_)
    q = rope(rms_norm(q, qn), pos)
    k = rope(rms_norm(k, kn), pos)
    qb = q.reshape(B_, nb, W, KVH, G, Dh)

    def band(t):
        tp = jnp.pad(t, ((0, 0), (W, 0), (0, 0), (0, 0))).reshape(B_, nb + 1, W, KVH, Dh)
        return jnp.concatenate([tp[:, :-1], tp[:, 1:]], axis=2)

    kb, vb = band(k), band(v)
    s = jnp.einsum('bnqkgd,bnjkd->bnkgqj', qb, kb).astype(jnp.float32) * Dh ** -0.5
    qi = jnp.arange(W)[:, None]
    kj = jnp.arange(2 * W)[None, :]
    diff = qi + W - kj
    key_pos = jnp.arange(nb)[:, None, None] * W - W + kj[None]
    mask = (diff >= 0)[None] & (diff < SWA_WINDOW)[None] & (key_pos >= 0)
    s = jnp.where(mask[None, :, None, None], s, -jnp.inf)
    sink = sinks.astype(jnp.float32).reshape(KVH, G)[None, None, :, :, None, None]
    m = jnp.maximum(jnp.max(s, axis=-1, keepdims=True), sink)
    e = jnp.exp(s - m)
    pr = e / (jnp.sum(e, axis=-1, keepdims=True) + jnp.exp(sink - m))
    o = jnp.einsum('bnkgqj,bnjkd->bnqkgd', pr.astype(vb.dtype), vb)
    return o.reshape(B_, S_, H * Dh)


def s5_glu(u, lam_re, lam_im, log_dt, b_re, b_im, c_re, c_im, d, glu_w, glu_b):
    B_, S_, _ = u.shape
    f32 = jnp.float32
    u32 = u.astype(f32)
    ug = u32.reshape(B_, S_, S5_GROUPS, S5_GROUP)
    lam = lax.complex(lam_re.astype(f32), lam_im.astype(f32))
    dt = jnp.exp(log_dt.astype(f32))[:, None]
    lam_bar = jnp.exp(lam * dt)
    bmat = lax.complex(b_re.astype(f32), b_im.astype(f32))
    b_bar = ((lam_bar - 1.0) / lam)[..., None] * bmat
    bu = jnp.einsum('gpc,bsgc->bsgp', b_bar, ug.astype(jnp.complex64))
    a = jnp.broadcast_to(lam_bar[None, None], (1, S_, S5_GROUPS, S5_STATE))
    _, h = lax.associative_scan(linear_scan_combine, (a, bu), axis=1)
    cmat = lax.complex(c_re.astype(f32), c_im.astype(f32))
    y = jnp.real(jnp.einsum('gcp,bsgp->bsgc', cmat, h)).reshape(B_, S_, S5_WIDTH)
    y = y + d.astype(f32) * u32
    z = jax.nn.gelu(y).astype(u.dtype)
    return z * jax.nn.sigmoid(z @ glu_w + glu_b)


def even_mixer(h, w_in, conv_w, conv_b, wa, ba, wx, bx, lam, b_f, qn, kn, w_out):
    B_, S_, _ = h.shape
    z = h @ w_in
    o1 = LRU_WIDTH
    o2 = o1 + LRU_WIDTH
    o3 = o2 + FOX_DIM
    o4 = o3 + FOX_DIM
    o5 = o4 + FOX_DIM
    xa, ya, q, k, v, f = jnp.split(z, [o1, o2, o3, o4, o5], axis=-1)
    a_out = jax.nn.gelu(ya) * rg_lru(xa, conv_w, conv_b, wa, ba, wx, bx, lam)
    hd = (B_, S_, FOX_HEADS, HEAD_DIM)
    b_out = fox_attention(q.reshape(hd), k.reshape(hd), v.reshape(hd), f, b_f, qn, kn)
    return jnp.concatenate([a_out, b_out], axis=-1) @ w_out


def odd_mixer(h, w_in, qn, kn, sinks, lam_re, lam_im, log_dt, b_re, b_im, c_re, c_im, d,
              glu_w, glu_b, w_out):
    B_, S_, _ = h.shape
    z = h @ w_in
    kvd = SWA_KV_HEADS * HEAD_DIM
    o1 = SWA_DIM
    o2 = o1 + kvd
    o3 = o2 + kvd
    q, k, v, u = jnp.split(z, [o1, o2, o3], axis=-1)
    c_out = swa_sink_attention(q.reshape(B_, S_, SWA_HEADS, HEAD_DIM),
                               k.reshape(B_, S_, SWA_KV_HEADS, HEAD_DIM),
                               v.reshape(B_, S_, SWA_KV_HEADS, HEAD_DIM), sinks, qn, kn)
    d_out = s5_glu(u, lam_re, lam_im, log_dt, b_re, b_im, c_re, c_im, d, glu_w, glu_b)
    return jnp.concatenate([c_out, d_out], axis=-1) @ w_out


def setup_inputs(seed: int = 0) -> dict:
    key = jax.random.key(seed)
    ks = iter(jax.random.split(key, 64))
    f32 = jnp.float32

    def nrm(shape, scale):
        return jax.random.normal(next(ks), shape, f32) * scale

    def gain(shape):
        return 1.0 + 0.02 * jax.random.normal(next(ks), shape, f32)

    D, F, NE, NO = D_MODEL, D_FF, N_EVEN, N_ODD
    x = nrm((BATCH, SEQ, D), 1.0)
    p = nrm((DEPTH, BATCH, SEQ, PLE_DIM), 1.0)
    ffn1_norm = gain((DEPTH, D))
    ffn1_wg = nrm((DEPTH, D, F), D ** -0.5)
    ffn1_wu = nrm((DEPTH, D, F), D ** -0.5)
    ffn1_wd = nrm((DEPTH, F, D), F ** -0.5)
    mix_norm = gain((DEPTH, D))
    ffn2_norm = gain((DEPTH, D))
    ffn2_wg = nrm((DEPTH, D, F), D ** -0.5)
    ffn2_wu = nrm((DEPTH, D, F), D ** -0.5)
    ffn2_wd = nrm((DEPTH, F, D), F ** -0.5)
    ple_w = nrm((DEPTH, PLE_DIM, D), PLE_DIM ** -0.5)
    ple_norm = gain((DEPTH, D))
    ple_gate_norm = gain((DEPTH, D))
    ple_gate_w = nrm((DEPTH, D, D), D ** -0.5)
    ev_w_in = nrm((NE, D, EV_IN), D ** -0.5)
    lru_conv_w = nrm((NE, LRU_CONV, LRU_WIDTH), LRU_CONV ** -0.5)
    lru_conv_b = nrm((NE, LRU_WIDTH), 0.01)
    bs = LRU_WIDTH // LRU_BLOCKS
    lru_wa = nrm((NE, LRU_BLOCKS, bs, bs), bs ** -0.5)
    lru_ba = nrm((NE, LRU_WIDTH), 0.01)
    lru_wx = nrm((NE, LRU_BLOCKS, bs, bs), bs ** -0.5)
    lru_bx = nrm((NE, LRU_WIDTH), 0.01)
    unif = jax.random.uniform(next(ks), (NE, LRU_WIDTH), f32, LRU_MIN_RAD ** 2, LRU_MAX_RAD ** 2)
    lru_lambda = jnp.log(jnp.expm1(-0.5 * jnp.log(unif)))
    fox_bf = jax.random.uniform(next(ks), (NE, FOX_HEADS), f32, 1.0, 5.0)
    fox_q_norm = gain((NE, HEAD_DIM))
    fox_k_norm = gain((NE, HEAD_DIM))
    ev_w_out = nrm((NE, MIX_WIDTH, D), MIX_WIDTH ** -0.5 * OUT_SCALE)
    od_w_in = nrm((NO, D, OD_IN), D ** -0.5)
    swa_q_norm = gain((NO, HEAD_DIM))
    swa_k_norm = gain((NO, HEAD_DIM))
    swa_sinks = nrm((NO, SWA_HEADS), 0.5)
    n_idx = jnp.arange(S5_STATE, dtype=f32)
    s5_lambda_re = -0.5 + nrm((NO, S5_GROUPS, S5_STATE), 0.01)
    s5_lambda_im = jnp.pi * n_idx + nrm((NO, S5_GROUPS, S5_STATE), 0.01)
    s5_log_dt = jax.random.uniform(next(ks), (NO, S5_GROUPS), f32, math.log(1e-3), math.log(1e-1))
    s5_b_re = nrm((NO, S5_GROUPS, S5_STATE, S5_GROUP), (2 * S5_GROUP) ** -0.5)
    s5_b_im = nrm((NO, S5_GROUPS, S5_STATE, S5_GROUP), (2 * S5_GROUP) ** -0.5)
    s5_c_re = nrm((NO, S5_GROUPS, S5_GROUP, S5_STATE), S5_STATE ** -0.5)
    s5_c_im = nrm((NO, S5_GROUPS, S5_GROUP, S5_STATE), S5_STATE ** -0.5)
    s5_d = nrm((NO, S5_WIDTH), 1.0)
    s5_glu_w = nrm((NO, S5_WIDTH, S5_WIDTH), S5_WIDTH ** -0.5)
    s5_glu_b = nrm((NO, S5_WIDTH), 0.01)
    od_w_out = nrm((NO, MIX_WIDTH, D), MIX_WIDTH ** -0.5 * OUT_SCALE)
    return {
        "x": x, "p": p,
        "ffn1_norm": ffn1_norm, "ffn1_wg": ffn1_wg, "ffn1_wu": ffn1_wu, "ffn1_wd": ffn1_wd,
        "mix_norm": mix_norm,
        "ffn2_norm": ffn2_norm, "ffn2_wg": ffn2_wg, "ffn2_wu": ffn2_wu, "ffn2_wd": ffn2_wd,
        "ple_w": ple_w, "ple_norm": ple_norm, "ple_gate_norm": ple_gate_norm, "ple_gate_w": ple_gate_w,
        "ev_w_in": ev_w_in, "lru_conv_w": lru_conv_w, "lru_conv_b": lru_conv_b,
        "lru_wa": lru_wa, "lru_ba": lru_ba, "lru_wx": lru_wx, "lru_bx": lru_bx,
        "lru_lambda": lru_lambda, "fox_bf": fox_bf, "fox_q_norm": fox_q_norm,
        "fox_k_norm": fox_k_norm, "ev_w_out": ev_w_out,
        "od_w_in": od_w_in, "swa_q_norm": swa_q_norm, "swa_k_norm": swa_k_norm,
        "swa_sinks": swa_sinks, "s5_lambda_re": s5_lambda_re, "s5_lambda_im": s5_lambda_im,
        "s5_log_dt": s5_log_dt, "s5_b_re": s5_b_re, "s5_b_im": s5_b_im,
        "s5_c_re": s5_c_re, "s5_c_im": s5_c_im, "s5_d": s5_d,
        "s5_glu_w": s5_glu_w, "s5_glu_b": s5_glu_b, "od_w_out": od_w_out,
    }


def reference(x, p, ffn1_norm, ffn1_wg, ffn1_wu, ffn1_wd, mix_norm,
              ffn2_norm, ffn2_wg, ffn2_wu, ffn2_wd,
              ple_w, ple_norm, ple_gate_norm, ple_gate_w,
              ev_w_in, lru_conv_w, lru_conv_b, lru_wa, lru_ba, lru_wx, lru_bx,
              lru_lambda, fox_bf, fox_q_norm, fox_k_norm, ev_w_out,
              od_w_in, swa_q_norm, swa_k_norm, swa_sinks, s5_lambda_re, s5_lambda_im,
              s5_log_dt, s5_b_re, s5_b_im, s5_c_re, s5_c_im, s5_d,
              s5_glu_w, s5_glu_b, od_w_out):
    for i in range(DEPTH):
        x = x + MACARON * swiglu(rms_norm(x, ffn1_norm[i]), ffn1_wg[i], ffn1_wu[i], ffn1_wd[i])
        h = rms_norm(x, mix_norm[i])
        if i % 2 == 0:
            j = i // 2
            x = x + even_mixer(h, ev_w_in[j], lru_conv_w[j], lru_conv_b[j], lru_wa[j], lru_ba[j],
                               lru_wx[j], lru_bx[j], lru_lambda[j], fox_bf[j],
                               fox_q_norm[j], fox_k_norm[j], ev_w_out[j])
        else:
            j = i // 2
            x = x + odd_mixer(h, od_w_in[j], swa_q_norm[j], swa_k_norm[j], swa_sinks[j],
                              s5_lambda_re[j], s5_lambda_im[j], s5_log_dt[j], s5_b_re[j],
                              s5_b_im[j], s5_c_re[j], s5_c_im[j], s5_d[j],
                              s5_glu_w[j], s5_glu_b[j], od_w_out[j])
        x = x + MACARON * swiglu(rms_norm(x, ffn2_norm[i]), ffn2_wg[i], ffn2_wu[i], ffn2_wd[i])
        e = rms_norm(p[i] @ ple_w[i], ple_norm[i])
        g = jax.nn.sigmoid(rms_norm(x, ple_gate_norm[i]) @ ple_gate_w[i])
        x = x + g * e
    return x
```

```cpp
#include <hip/hip_runtime.h>
#include <hip/hip_cooperative_groups.h>
#include <cstdio>
#include <cstdint>
namespace cg = cooperative_groups;

typedef unsigned short u16;
using bf16x8 = __attribute__((ext_vector_type(8))) short;
using s16x4 = __attribute__((ext_vector_type(4))) short;
using f32x4 = __attribute__((ext_vector_type(4))) float;
using f32x16 = __attribute__((ext_vector_type(16))) float;

constexpr int T = 32768, SEQ = 4096;
constexpr float EPS = 1e-6f;
constexpr float LOG2E = 1.4426950408889634f;
constexpr float QSCALE = 0.125f * LOG2E;

enum { I_X, I_P, I_F1N, I_F1G, I_F1U, I_F1D, I_MIXN, I_F2N, I_F2G, I_F2U, I_F2D, I_PLEW, I_PLEN, I_PLEGN, I_PLEGW,
       I_EVIN, I_CONVW, I_CONVB, I_WA, I_BA, I_WX, I_BX, I_LAM, I_FOXBF, I_FOXQN, I_FOXKN, I_EVOUT,
       I_ODIN, I_SWAQN, I_SWAKN, I_SINKS, I_S5LRE, I_S5LIM, I_S5LOGDT, I_S5BRE, I_S5BIM, I_S5CRE, I_S5CIM, I_S5D,
       I_GLUW, I_GLUB, I_ODOUT, N_IN };

struct Params {
  const float* in[N_IN];
  float* out;
  char* ws;
};

constexpr size_t SZ_FFNGU = (size_t)5632 * 1024 * 2, SZ_FFND = (size_t)1024 * 2816 * 2;
constexpr size_t OFF_W_F1GU = 0;
constexpr size_t OFF_W_F1D = OFF_W_F1GU + 4 * SZ_FFNGU;
constexpr size_t OFF_W_F2GU = OFF_W_F1D + 4 * SZ_FFND;
constexpr size_t OFF_W_F2D = OFF_W_F2GU + 4 * SZ_FFNGU;
constexpr size_t OFF_W_PLE = OFF_W_F2D + 4 * SZ_FFND;
constexpr size_t OFF_W_GATE = OFF_W_PLE + 4 * (size_t)1024 * 256 * 2;
constexpr size_t OFF_W_EVIN = OFF_W_GATE + 4 * (size_t)1024 * 1024 * 2;
constexpr size_t OFF_W_EVOUT = OFF_W_EVIN + 2 * (size_t)2816 * 1024 * 2;
constexpr size_t OFF_W_ODIN = OFF_W_EVOUT + 2 * (size_t)1024 * 1024 * 2;
constexpr size_t OFF_W_ODOUT = OFF_W_ODIN + 2 * (size_t)1280 * 1024 * 2;
constexpr size_t OFF_W_GLU = OFF_W_ODOUT + 2 * (size_t)1024 * 1024 * 2;
constexpr size_t OFF_W_ODV = OFF_W_GLU + 2 * (size_t)512 * 512 * 2;
constexpr size_t OFF_W_LRU = OFF_W_ODV + 2 * (size_t)256 * 1024 * 2;
constexpr size_t OFF_BUFX = OFF_W_LRU + (size_t)2 * 2 * 8 * 64 * 64 * 2;
constexpr size_t OFF_BUFY = OFF_BUFX + (size_t)T * 1024 * 2;
constexpr size_t OFF_PE = OFF_BUFY + (size_t)T * 1024 * 2;
constexpr size_t OFF_PBF = OFF_PE + (size_t)T * 1024 * 2;
constexpr size_t OFF_BIG = OFF_PBF + (size_t)T * 256 * 2;
constexpr size_t SZ_BIG = (size_t)T * 2816 * 2;
constexpr size_t OFF_SS = OFF_BIG + SZ_BIG;
constexpr size_t OFF_SSPE = OFF_SS + (size_t)17 * T * 4;
constexpr size_t OFF_FLOG = OFF_SSPE + (size_t)4 * T * 4;
constexpr size_t OFF_C2 = OFF_FLOG + (size_t)T * 8 * 4;
constexpr size_t OFF_LRUAGG = OFF_C2 + (size_t)64 * 4096 * 4;
constexpr size_t OFF_S5END = OFF_LRUAGG + (size_t)8 * 64 * 512 * 2 * 4;
constexpr size_t OFF_ROPE = OFF_S5END + (size_t)8 * 64 * 32 * 64 * 8;
constexpr size_t OFF_BAR = OFF_ROPE + (size_t)4096 * 32 * 8;
constexpr size_t WS_TOTAL = OFF_BAR + 16384;

constexpr int LDS_BYTES = 139264 + 16;
constexpr int LDS_WAVE = 17408;

__device__ __forceinline__ int lane_id_v() {
  int l;
  asm volatile("v_mbcnt_lo_u32_b32 %0, -1, 0\n\tv_mbcnt_hi_u32_b32 %0, -1, %0" : "=v"(l));
  return l;
}
__device__ __forceinline__ u16 f2bf(float f) {
  uint32_t u = __float_as_uint(f);
  u += 0x7fffu + ((u >> 16) & 1u);
  return (u16)(u >> 16);
}
__device__ __forceinline__ float bf2f(u16 h) { return __uint_as_float(((uint32_t)h) << 16); }
__device__ __forceinline__ uint32_t pack2(float a, float b) {
  uint32_t r;
  asm("v_cvt_pk_bf16_f32 %0, %1, %2" : "=v"(r) : "v"(a), "v"(b));
  return r;
}
__device__ __forceinline__ float sigmoidf_(float x) { return __builtin_amdgcn_rcpf(1.f + __expf(-x)); }
__device__ __forceinline__ float gelu_tanh(float x) {
  float u = 0.7978845608028654f * (x + 0.044715f * x * x * x);
  float e = __expf(2.f * u);
  float th = 1.f - 2.f * __builtin_amdgcn_rcpf(1.f + e);
  return 0.5f * x * (1.f + th);
}
__device__ __forceinline__ float ex2(float x) { return __builtin_amdgcn_exp2f(x); }
typedef unsigned u32x2_t __attribute__((ext_vector_type(2)));
__device__ __forceinline__ float xsum32(float x) {
  u32x2_t r = __builtin_amdgcn_permlane32_swap(__float_as_uint(x), __float_as_uint(x), false, false);
  return __uint_as_float(r.x) + __uint_as_float(r.y);
}
__device__ __forceinline__ float xmax32(float x) {
  u32x2_t r = __builtin_amdgcn_permlane32_swap(__float_as_uint(x), __float_as_uint(x), false, false);
  return fmaxf(__uint_as_float(r.x), __uint_as_float(r.y));
}
__device__ __forceinline__ float xsum16(float x) {
  u32x2_t r = __builtin_amdgcn_permlane16_swap(__float_as_uint(x), __float_as_uint(x), false, false);
  return __uint_as_float(r.x) + __uint_as_float(r.y);
}


struct TDesc {
  const float* src0;
  const float* src1;
  const float* gain;
  u16* dst;
  int ldsrc, Nlog, K, mode, coloff, tile;
};

__device__ __forceinline__ void transpose_tile(const TDesc& d, float* tile, int tid) {
  const int tiles_k = d.K / 64;
  const int tr = d.tile / tiles_k, tk = d.tile % tiles_k;
  const int r0 = tr * 256, k0 = tk * 64;
  {
    const int rq = (tid & 63) * 4, kq = tid >> 6;
    const int r = r0 + rq;
    const int c = r & 255;
    const float* sp = d.src0;
    int scol;
    bool valid = true;
    if (d.mode == 0) {
      scol = d.coloff + (r >> 8) * 256 + ((c & 127) >> 5) * 64 + (c >> 7) * 32 + (c & 31);
      valid = scol < d.Nlog;
    } else if (d.mode == 3) {
      const int p = c & 31;
      scol = d.coloff + (r >> 8) * 256 + ((c & 127) >> 5) * 64 + (c >> 7) * 32 + 8 * ((p >> 2) & 3) + 4 * (p >> 4) + (p & 3);
      valid = scol < d.Nlog;
    } else if (d.mode == 2) {
      scol = d.coloff + r;
      valid = scol < d.Nlog;
    } else {
      const int p = c & 31;
      scol = (r >> 8) * 128 + ((c & 127) >> 5) * 32 + 8 * ((p >> 2) & 3) + 4 * (p >> 4) + (p & 3);
      sp = (c >> 7) ? d.src1 : d.src0;
    }
    f32x4 v[8];
#pragma unroll
    for (int i = 0; i < 8; ++i) {
      const int k = k0 + kq + 8 * i;
      v[i] = valid ? *reinterpret_cast<const f32x4*>(sp + (size_t)k * d.ldsrc + scol) : (f32x4){0.f, 0.f, 0.f, 0.f};
    }
#pragma unroll
    for (int i = 0; i < 8; ++i) {
      const int kl = kq + 8 * i;
      const float g = d.gain ? d.gain[k0 + kl] : 1.f;
      float* tp = tile + kl * 257 + rq;
      tp[0] = v[i][0] * g; tp[1] = v[i][1] * g; tp[2] = v[i][2] * g; tp[3] = v[i][3] * g;
    }
  }
  __syncthreads();
  {
    const int rl = tid >> 1, kseg = (tid & 1) * 32;
    u16* dp = d.dst + (size_t)(r0 + rl) * d.K + k0 + kseg;
#pragma unroll
    for (int q = 0; q < 4; ++q) {
      const float* tp = tile + (kseg + q * 8) * 257 + rl;
      uint4 pk;
      pk.x = pack2(tp[0 * 257], tp[1 * 257]);
      pk.y = pack2(tp[2 * 257], tp[3 * 257]);
      pk.z = pack2(tp[4 * 257], tp[5 * 257]);
      pk.w = pack2(tp[6 * 257], tp[7 * 257]);
      *reinterpret_cast<uint4*>(dp + q * 8) = pk;
    }
  }
  __syncthreads();
}

constexpr int TL_LAYER = 1136, TL_MIX = 416, TL_TOTAL = 4 * TL_LAYER + 2 * TL_MIX;
__device__ __forceinline__ TDesc weight_tile_desc(const Params& P, int g) {
  TDesc d{};
  char* ws = P.ws;
  if (g < 4 * TL_LAYER) {
    const int l = g / TL_LAYER, r = g % TL_LAYER;
    if (r < 704) {
      const bool second = r >= 352;
      d.tile = second ? r - 352 : r;
      d.src0 = P.in[second ? I_F2G : I_F1G] + (size_t)l * 1024 * 2816;
      d.src1 = P.in[second ? I_F2U : I_F1U] + (size_t)l * 1024 * 2816;
      d.gain = P.in[second ? I_F2N : I_F1N] + l * 1024;
      d.dst = reinterpret_cast<u16*>(ws + (second ? OFF_W_F2GU : OFF_W_F1GU) + l * SZ_FFNGU);
      d.ldsrc = 2816; d.Nlog = 0; d.K = 1024; d.mode = 1; d.coloff = 0;
    } else if (r < 1056) {
      const bool second = r >= 880;
      d.tile = second ? r - 880 : r - 704;
      d.src0 = P.in[second ? I_F2D : I_F1D] + (size_t)l * 2816 * 1024;
      d.dst = reinterpret_cast<u16*>(ws + (second ? OFF_W_F2D : OFF_W_F1D) + l * SZ_FFND);
      d.ldsrc = 1024; d.Nlog = 1024; d.K = 2816; d.mode = 3;
    } else if (r < 1072) {
      d.tile = r - 1056;
      d.src0 = P.in[I_PLEW] + (size_t)l * 256 * 1024;
      d.dst = reinterpret_cast<u16*>(ws + OFF_W_PLE + (size_t)l * 1024 * 256 * 2);
      d.ldsrc = 1024; d.Nlog = 1024; d.K = 256; d.mode = 3;
    } else {
      d.tile = r - 1072;
      d.src0 = P.in[I_PLEGW] + (size_t)l * 1024 * 1024;
      d.gain = P.in[I_PLEGN] + l * 1024;
      d.dst = reinterpret_cast<u16*>(ws + OFF_W_GATE + (size_t)l * 1024 * 1024 * 2);
      d.ldsrc = 1024; d.Nlog = 1024; d.K = 1024; d.mode = 3;
    }
  } else {
    const int g2 = g - 4 * TL_LAYER;
    const int j = g2 / TL_MIX, r = g2 % TL_MIX;
    if (r < 176) {
      d.src0 = P.in[I_EVIN] + (size_t)j * 1024 * 2568;
      d.gain = P.in[I_MIXN] + (2 * j) * 1024;
      u16* dst = reinterpret_cast<u16*>(ws + OFF_W_EVIN + (size_t)j * 2816 * 1024 * 2);
      d.ldsrc = 2568; d.K = 1024;
      if (r < 128) { d.tile = r; d.dst = dst; d.Nlog = 2048; d.mode = 0; d.coloff = 0; }
      else if (r < 144) { d.tile = r - 128; d.dst = dst + (size_t)2048 * 1024; d.Nlog = 2568; d.mode = 0; d.coloff = 2560; }
      else { d.tile = r - 144; d.dst = dst + (size_t)2304 * 1024; d.Nlog = 2560; d.mode = 2; d.coloff = 2048; }
    } else if (r < 240) {
      d.tile = r - 176;
      d.src0 = P.in[I_EVOUT] + (size_t)j * 1024 * 1024;
      d.dst = reinterpret_cast<u16*>(ws + OFF_W_EVOUT + (size_t)j * 1024 * 1024 * 2);
      d.ldsrc = 1024; d.Nlog = 1024; d.K = 1024; d.mode = 3;
    } else if (r < 336) {
      d.src0 = P.in[I_ODIN] + (size_t)j * 1024 * 1280;
      d.gain = P.in[I_MIXN] + (2 * j + 1) * 1024;
      d.ldsrc = 1280; d.K = 1024;
      if (r < 320) { d.tile = r - 240; d.dst = reinterpret_cast<u16*>(ws + OFF_W_ODIN + (size_t)j * 1280 * 1024 * 2); d.Nlog = 1280; d.mode = 0; d.coloff = 0; }
      else { d.tile = r - 320; d.dst = reinterpret_cast<u16*>(ws + OFF_W_ODV + (size_t)j * 256 * 1024 * 2); d.Nlog = 768; d.mode = 2; d.coloff = 640; }
    } else if (r < 400) {
      d.tile = r - 336;
      d.src0 = P.in[I_ODOUT] + (size_t)j * 1024 * 1024;
      d.dst = reinterpret_cast<u16*>(ws + OFF_W_ODOUT + (size_t)j * 1024 * 1024 * 2);
      d.ldsrc = 1024; d.Nlog = 1024; d.K = 1024; d.mode = 3;
    } else {
      d.tile = r - 400;
      d.src0 = P.in[I_GLUW] + (size_t)j * 512 * 512;
      d.dst = reinterpret_cast<u16*>(ws + OFF_W_GLU + (size_t)j * 512 * 512 * 2);
      d.ldsrc = 512; d.Nlog = 512; d.K = 512; d.mode = 0;
    }
  }
  return d;
}

#define LAS __attribute__((address_space(3)))
constexpr int BM = 256, BK = 64, HALF = 128, HTB = HALF * BK * 2;

__device__ __forceinline__ int lds_byte(int r, int c) {
  const int st = (r >> 4) * 2 + (c >> 5), rr = r & 15, cc = c & 31, ob = rr * 64 + cc * 2;
  return st * 1024 + (ob ^ (((ob >> 9) & 1) << 5));
}
__device__ __forceinline__ void stage_rc(int b, int& R, int& C) {
  const int st = b / 1024, sb = b % 1024, swz = sb ^ (((sb >> 9) & 1) << 5);
  R = (st >> 1) * 16 + swz / 64;
  C = (st & 1) * 32 + (swz % 64) / 2;
}

struct Unit { int pm, pn; };
struct Order {
  int nM, nN, nwg, spx, qx, xcd, off;
  bool remap;
  __device__ __forceinline__ void init(int M, int N, int offshift) {
    nM = M / BM; nN = N / BM; nwg = nM * nN;
    remap = ((gridDim.x & 7) == 0) && ((nwg & 7) == 0);
    spx = gridDim.x >> 3; qx = nwg >> 3; xcd = blockIdx.x & 7; off = blockIdx.x >> 3;
    if (remap && offshift) off = (off + offshift) % spx;
  }
  __device__ __forceinline__ bool next(int it, Unit& u) const {
    int wg;
    if (remap) {
      int li = it * spx + off;
      if (li >= qx) return false;
      wg = xcd * qx + li;
    } else {
      wg = it * (int)gridDim.x + (int)blockIdx.x;
      if (wg >= nwg) return false;
    }
    const int nig = 8 * nN, gid = wg / nig, fm = gid * 8, gsz = (nM - fm) < 8 ? (nM - fm) : 8;
    u.pm = fm + ((wg % nig) % gsz);
    u.pn = (wg % nig) / gsz;
    return true;
  }
};

enum { EPI_SWIGLU, EPI_RESID, EPI_EVEN, EPI_ODD, EPI_PE, EPI_PLEGATE, EPI_GLU, EPI_VT };

struct EpiArgs {
  const float* ss_in;
  float* ss_out;
  const u16* hi_in;
  const u16* lo_in;
  u16* lo_out;
  float* xf32_out;
  u16* xb_out;
  u16* out_bf;
  const u16* aux_bf;
  const float* aux_f0;
  const float* aux_f1;
  const float* aux_f2;
  u16* vt;
  u16* kp;
  float* flog;
  float alpha;
  int nh;
};

__device__ __forceinline__ float rstd_of(float ssv) { return rsqrtf(ssv * (1.f / 1024.f) + EPS); }
__device__ __forceinline__ uint2 pack4(f32x4 v) {
  uint2 r;
  r.x = pack2(v[0], v[1]);
  r.y = pack2(v[2], v[3]);
  return r;
}

template <int EPI>
__device__ __forceinline__ void gemm_epilogue(const f32x4 (&acc)[2][2][4][2], const Unit& u, int wr, int wc, int fr, int fq,
                                              const EpiArgs& ea, const float (&rs_pre)[2][4]) {
  const int row0 = u.pm * 256 + wr * 64 + fr;
  const int lc0 = u.pn * 256 + wc * 64 + 4 * fq;
  float rsr[2][4];
  if constexpr (EPI == EPI_SWIGLU || EPI == EPI_PLEGATE || EPI == EPI_EVEN || EPI == EPI_ODD) {
#pragma unroll
    for (int ai = 0; ai < 2; ++ai)
#pragma unroll
      for (int m = 0; m < 4; ++m)
        rsr[ai][m] = (EPI == EPI_SWIGLU || EPI == EPI_PLEGATE) ? rs_pre[ai][m] : ea.ss_in[row0 + ai * 128 + m * 16];
#pragma unroll
    for (int ai = 0; ai < 2; ++ai)
#pragma unroll
      for (int m = 0; m < 4; ++m) rsr[ai][m] = rstd_of(rsr[ai][m]);
  }
  if constexpr (EPI == EPI_SWIGLU) {
#pragma unroll
    for (int ai = 0; ai < 2; ++ai)
#pragma unroll
      for (int m = 0; m < 4; ++m) {
        const int row = row0 + ai * 128 + m * 16;
        const float rs = rsr[ai][m];
        u16* rowp = ea.out_bf + (size_t)row * 2816 + u.pn * 128 + wc * 32 + 8 * fq;
        uint2 hp2[2];
#pragma unroll
        for (int n = 0; n < 2; ++n) {
          f32x4 g = acc[ai][0][m][n] * rs, uu = acc[ai][1][m][n] * rs, h;
#pragma unroll
          for (int i = 0; i < 4; ++i) h[i] = g[i] * sigmoidf_(g[i]) * uu[i];
          hp2[n] = pack4(h);
        }
        *reinterpret_cast<uint4*>(rowp) = make_uint4(hp2[0].x, hp2[0].y, hp2[1].x, hp2[1].y);
      }
  } else if constexpr (EPI == EPI_RESID || EPI == EPI_PLEGATE) {
    float rper[2][4];
    if constexpr (EPI == EPI_PLEGATE) {
#pragma unroll
      for (int ai = 0; ai < 2; ++ai)
#pragma unroll
        for (int m = 0; m < 4; ++m) rper[ai][m] = ea.aux_f0[row0 + ai * 128 + m * 16];
#pragma unroll
      for (int ai = 0; ai < 2; ++ai)
#pragma unroll
        for (int m = 0; m < 4; ++m) rper[ai][m] = rstd_of(rper[ai][m]);
    }
    const int lcp = u.pn * 256 + wc * 64 + 8 * fq;
    uint4 hc[2], hn[2], lc[2], ln_[2], pc[2], pq[2];
#define EPI_LOAD_ROW(IT, HH, LL, PP)                                                                  \
  {                                                                                                   \
    const size_t rb_ = (size_t)(row0 + ((IT) >> 2) * 128 + ((IT)&3) * 16) * 1024 + lcp;               \
    _Pragma("unroll") for (int bj = 0; bj < 2; ++bj) {                                                \
      HH[bj] = *reinterpret_cast<const uint4*>(ea.hi_in + rb_ + bj * 32);                             \
      LL[bj] = *reinterpret_cast<const uint4*>(ea.lo_in + rb_ + bj * 32);                             \
      if constexpr (EPI == EPI_PLEGATE) PP[bj] = *reinterpret_cast<const uint4*>(ea.aux_bf + rb_ + bj * 32); \
    }                                                                                                 \
  }
    EPI_LOAD_ROW(0, hc, lc, pc);
#pragma unroll
    for (int it = 0; it < 8; ++it) {
      const int ai = it >> 2, m = it & 3;
      if (it + 1 < 8) EPI_LOAD_ROW(it + 1, hn, ln_, pq);
      const int row = row0 + ai * 128 + m * 16;
      float sq = 0.f;
#pragma unroll
      for (int bj = 0; bj < 2; ++bj) {
        const size_t idx = (size_t)row * 1024 + lcp + bj * 32;
        const uint32_t hw[4] = {hc[bj].x, hc[bj].y, hc[bj].z, hc[bj].w};
        const uint32_t lw[4] = {lc[bj].x, lc[bj].y, lc[bj].z, lc[bj].w};
        const uint32_t pw[4] = {pc[bj].x, pc[bj].y, pc[bj].z, pc[bj].w};
        uint32_t ho[4], lo_[4];
#pragma unroll
        for (int n = 0; n < 2; ++n) {
          f32x4 xv;
          xv[0] = __uint_as_float(hw[2 * n] << 16) + __uint_as_float(lw[2 * n] << 16);
          xv[1] = __uint_as_float(hw[2 * n] & 0xffff0000u) + __uint_as_float(lw[2 * n] & 0xffff0000u);
          xv[2] = __uint_as_float(hw[2 * n + 1] << 16) + __uint_as_float(lw[2 * n + 1] << 16);
          xv[3] = __uint_as_float(hw[2 * n + 1] & 0xffff0000u) + __uint_as_float(lw[2 * n + 1] & 0xffff0000u);
          const f32x4 a = acc[ai][bj][m][n];
          f32x4 v;
          if constexpr (EPI == EPI_PLEGATE) {
            const float rs = rsr[ai][m], rpe = rper[ai][m];
            const float pv[4] = {__uint_as_float(pw[2 * n] << 16), __uint_as_float(pw[2 * n] & 0xffff0000u),
                                 __uint_as_float(pw[2 * n + 1] << 16), __uint_as_float(pw[2 * n + 1] & 0xffff0000u)};
#pragma unroll
            for (int i = 0; i < 4; ++i) v[i] = xv[i] + sigmoidf_(a[i] * rs) * (pv[i] * rpe);
          } else {
            v = xv + a * ea.alpha;
          }
          const uint2 hnew = pack4(v);
          ho[2 * n] = hnew.x; ho[2 * n + 1] = hnew.y;
          if (ea.xf32_out) {
            *reinterpret_cast<f32x4*>(ea.xf32_out + idx + 4 * n) = v;
          } else {
            f32x4 r;
            r[0] = v[0] - __uint_as_float(hnew.x << 16);
            r[1] = v[1] - __uint_as_float(hnew.x & 0xffff0000u);
            r[2] = v[2] - __uint_as_float(hnew.y << 16);
            r[3] = v[3] - __uint_as_float(hnew.y & 0xffff0000u);
            const uint2 lnew = pack4(r);
            lo_[2 * n] = lnew.x; lo_[2 * n + 1] = lnew.y;
          }
          sq += v[0] * v[0] + v[1] * v[1] + v[2] * v[2] + v[3] * v[3];
        }
        if (!ea.xf32_out) {
          *reinterpret_cast<uint4*>(ea.xb_out + idx) = make_uint4(ho[0], ho[1], ho[2], ho[3]);
          *reinterpret_cast<uint4*>(ea.lo_out + idx) = make_uint4(lo_[0], lo_[1], lo_[2], lo_[3]);
        }
      }
      sq = xsum32(xsum16(sq));
      if (fq == 0) atomicAdd(&ea.ss_out[row], sq);
      if (it + 1 < 8) {
#pragma unroll
        for (int bj = 0; bj < 2; ++bj) { hc[bj] = hn[bj]; lc[bj] = ln_[bj]; pc[bj] = pq[bj]; }
      }
    }
#undef EPI_LOAD_ROW
  } else if constexpr (EPI == EPI_PE) {
    const int lcp = u.pn * 256 + wc * 64 + 8 * fq;
    f32x4 gnv[2][2];
#pragma unroll
    for (int bj = 0; bj < 2; ++bj)
#pragma unroll
      for (int n = 0; n < 2; ++n) gnv[bj][n] = *reinterpret_cast<const f32x4*>(ea.aux_f1 + lcp + bj * 32 + 4 * n);
#pragma unroll
    for (int ai = 0; ai < 2; ++ai)
#pragma unroll
      for (int m = 0; m < 4; ++m) {
        const int row = row0 + ai * 128 + m * 16;
        float sq = 0.f;
#pragma unroll
        for (int bj = 0; bj < 2; ++bj) {
          uint2 pk2[2];
#pragma unroll
          for (int n = 0; n < 2; ++n) {
            f32x4 a = acc[ai][bj][m][n];
            pk2[n] = pack4(a * gnv[bj][n]);
            sq += a[0] * a[0] + a[1] * a[1] + a[2] * a[2] + a[3] * a[3];
          }
          *reinterpret_cast<uint4*>(ea.out_bf + (size_t)row * 1024 + lcp + bj * 32) = make_uint4(pk2[0].x, pk2[0].y, pk2[1].x, pk2[1].y);
        }
        sq = xsum32(xsum16(sq));
        if (fq == 0) atomicAdd(&ea.ss_out[row], sq);
      }
  } else if constexpr (EPI == EPI_GLU) {
    f32x4 gbv[2][2];
#pragma unroll
    for (int bj = 0; bj < 2; ++bj)
#pragma unroll
      for (int n = 0; n < 2; ++n) gbv[bj][n] = *reinterpret_cast<const f32x4*>(ea.aux_f0 + lc0 + bj * 32 + n * 16);
    uint2 zc[2][2], zn[2][2];
#pragma unroll
    for (int bj = 0; bj < 2; ++bj)
#pragma unroll
      for (int n = 0; n < 2; ++n) zc[bj][n] = *reinterpret_cast<const uint2*>(ea.aux_bf + (size_t)row0 * 512 + lc0 + bj * 32 + n * 16);
#pragma unroll
    for (int it = 0; it < 8; ++it) {
      const int ai = it >> 2, m = it & 3;
      const int row = row0 + ai * 128 + m * 16;
      if (it + 1 < 8) {
        const int rown = row0 + ((it + 1) >> 2) * 128 + ((it + 1) & 3) * 16;
#pragma unroll
        for (int bj = 0; bj < 2; ++bj)
#pragma unroll
          for (int n = 0; n < 2; ++n) zn[bj][n] = *reinterpret_cast<const uint2*>(ea.aux_bf + (size_t)rown * 512 + lc0 + bj * 32 + n * 16);
      }
#pragma unroll
      for (int bj = 0; bj < 2; ++bj)
#pragma unroll
        for (int n = 0; n < 2; ++n) {
          const int col = lc0 + bj * 32 + n * 16;
          const uint2 zw = zc[bj][n];
          const float zv[4] = {__uint_as_float(zw.x << 16), __uint_as_float(zw.x & 0xffff0000u), __uint_as_float(zw.y << 16),
                               __uint_as_float(zw.y & 0xffff0000u)};
          f32x4 a = acc[ai][bj][m][n], o;
#pragma unroll
          for (int i = 0; i < 4; ++i) o[i] = zv[i] * sigmoidf_(a[i] + gbv[bj][n][i]);
          *reinterpret_cast<uint2*>(ea.out_bf + (size_t)row * 1024 + 512 + col) = pack4(o);
        }
      if (it + 1 < 8) {
#pragma unroll
        for (int bj = 0; bj < 2; ++bj)
#pragma unroll
          for (int n = 0; n < 2; ++n) zc[bj][n] = zn[bj][n];
      }
    }
  } else if constexpr (EPI == EPI_EVEN || EPI == EPI_ODD) {
    const int unit = u.pn * 4 + wc;
    constexpr int LD = (EPI == EPI_EVEN) ? 1536 : 1280;
    const int qlo = (EPI == EPI_EVEN) ? 16 : 0, qhi = (EPI == EPI_EVEN) ? 24 : 8, khi = (EPI == EPI_EVEN) ? 32 : 10;
    const bool plain = (EPI == EPI_EVEN) ? (unit < 16) : (unit >= 12);
    if (plain) {
#pragma unroll
      for (int ai = 0; ai < 2; ++ai)
#pragma unroll
        for (int m = 0; m < 4; ++m) {
          const int row = row0 + ai * 128 + m * 16;
          const float rs = rsr[ai][m];
#pragma unroll
          for (int bj = 0; bj < 2; ++bj)
#pragma unroll
            for (int n = 0; n < 2; ++n)
              *reinterpret_cast<uint2*>(ea.out_bf + (size_t)row * LD + lc0 + bj * 32 + n * 16) = pack4(acc[ai][bj][m][n] * rs);
        }
    } else if (unit >= qlo && unit < khi) {
      const bool isq = unit < qhi;
      const float* gn = isq ? ea.aux_f0 : ea.aux_f1;
      const float sc = isq ? QSCALE : 1.f;
      f32x4 gv[2][2];
#pragma unroll
      for (int bj = 0; bj < 2; ++bj)
#pragma unroll
        for (int n = 0; n < 2; ++n) gv[bj][n] = *reinterpret_cast<const f32x4*>(gn + bj * 32 + n * 16 + 4 * fq) * sc;
#pragma unroll
      for (int ai = 0; ai < 2; ++ai)
#pragma unroll
        for (int m = 0; m < 4; ++m) {
          const int row = row0 + ai * 128 + m * 16;
          const float rs = rsr[ai][m];
          f32x4 v[2][2];
          float sq = 0.f;
#pragma unroll
          for (int bj = 0; bj < 2; ++bj)
#pragma unroll
            for (int n = 0; n < 2; ++n) {
              v[bj][n] = acc[ai][bj][m][n] * rs;
              sq += v[bj][n][0] * v[bj][n][0] + v[bj][n][1] * v[bj][n][1] + v[bj][n][2] * v[bj][n][2] + v[bj][n][3] * v[bj][n][3];
            }
          sq = xsum32(xsum16(sq));
          const float hr = rsqrtf(sq * (1.f / 64.f) + EPS);
#pragma unroll
          for (int bj = 0; bj < 2; ++bj)
#pragma unroll
            for (int n = 0; n < 2; ++n) v[bj][n] = v[bj][n] * hr * gv[bj][n];
          if constexpr (EPI == EPI_ODD) {
            const int pos = row & 4095;
            const float2* rope = reinterpret_cast<const float2*>(ea.aux_f2) + pos * 32 + 4 * fq;
#pragma unroll
            for (int n = 0; n < 2; ++n) {
              f32x4 c01 = *reinterpret_cast<const f32x4*>(rope + n * 16);
              f32x4 c23 = *reinterpret_cast<const f32x4*>(rope + n * 16 + 2);
              float cs[4] = {c01[0], c01[2], c23[0], c23[2]}, sn[4] = {c01[1], c01[3], c23[1], c23[3]};
              f32x4 x1 = v[0][n], x2 = v[1][n];
#pragma unroll
              for (int i = 0; i < 4; ++i) {
                v[0][n][i] = x1[i] * cs[i] - x2[i] * sn[i];
                v[1][n][i] = x2[i] * cs[i] + x1[i] * sn[i];
              }
            }
          }
          if (isq) {
#pragma unroll
            for (int bj = 0; bj < 2; ++bj)
#pragma unroll
              for (int n = 0; n < 2; ++n)
                *reinterpret_cast<uint2*>(ea.out_bf + (size_t)row * LD + lc0 + bj * 32 + n * 16) = pack4(v[bj][n]);
          } else {
            const int kh = unit - qhi, b = row >> 12, t = row & 4095;
            u16* kb = ea.kp + ((size_t)((b * ea.nh + kh) * 128 + (t >> 5)) * 4) * 512 + ((fq >> 1) * 32 + (t & 31)) * 8 + (fq & 1) * 4;
#pragma unroll
            for (int bj = 0; bj < 2; ++bj)
#pragma unroll
              for (int n = 0; n < 2; ++n) *reinterpret_cast<uint2*>(kb + (bj * 2 + n) * 512) = pack4(v[bj][n]);
          }
        }
    } else if (EPI == EPI_EVEN && unit == 32) {
      if (fq < 2) {
        f32x4 bfv = *reinterpret_cast<const f32x4*>(ea.aux_f2 + 4 * fq);
#pragma unroll
        for (int ai = 0; ai < 2; ++ai)
#pragma unroll
          for (int m = 0; m < 4; ++m) {
            const int row = row0 + ai * 128 + m * 16;
            const float rs = rsr[ai][m];
            f32x4 o;
#pragma unroll
            for (int i = 0; i < 4; ++i) {
              float xv = acc[ai][0][m][0][i] * rs + bfv[i];
              o[i] = fminf(xv, 0.f) - log1pf(__expf(-fabsf(xv)));
            }
            *reinterpret_cast<f32x4*>(ea.flog + (size_t)row * 8 + 4 * fq) = o;
          }
      }
    }
  } else if constexpr (EPI == EPI_VT) {
    f32x4 rsv[2][2];
#pragma unroll
    for (int bj = 0; bj < 2; ++bj)
#pragma unroll
      for (int n = 0; n < 2; ++n) rsv[bj][n] = *reinterpret_cast<const f32x4*>(ea.ss_in + u.pn * 256 + bj * 128 + wc * 32 + n * 16 + 4 * fq);
#pragma unroll
    for (int bj = 0; bj < 2; ++bj)
#pragma unroll
      for (int n = 0; n < 2; ++n) {
        const int tok = u.pn * 256 + bj * 128 + wc * 32 + n * 16 + 4 * fq;
        f32x4 rs;
#pragma unroll
        for (int i = 0; i < 4; ++i) rs[i] = rstd_of(rsv[bj][n][i]);
        const int b = tok >> 12, t = tok & 4095;
        const int tt = t & 31, uu = tt & 15;
        const int sub = (tt >> 4) * 512 + (((uu & 7) >> 2) * 32) * 8 + (uu >> 3) * 4;
#pragma unroll
        for (int ai = 0; ai < 2; ++ai) {
          const int hv = u.pm * 4 + ai * 2 + wr;
          if (hv < ea.nh) {
            u16* vb = ea.vt + ((size_t)((b * ea.nh + hv) * 128 + (t >> 5)) * 4) * 512 + sub;
#pragma unroll
            for (int m = 0; m < 4; ++m) {
              const int d = m * 16 + fr;
              *reinterpret_cast<uint2*>(vb + (d >> 5) * 1024 + (d & 31) * 8) = pack4(acc[ai][bj][m][n] * rs);
            }
          }
        }
      }
  }
}

template <int EPI>
__device__ __forceinline__ void gemm_phase(const u16* __restrict__ Ag, const u16* __restrict__ Btg, int M, int N, int K,
                                           const EpiArgs& ea, const int wid, const int offshift = 0) {
  asm volatile("" : "+s"(K));
  extern __shared__ __attribute__((aligned(16))) char shm_raw[];
  LAS unsigned char* lds = (LAS unsigned char*)shm_raw;
  const int lane = lane_id_v(), tid = wid * 64 + lane, wr = wid >> 2, wc = wid & 3, fr = lane & 15, fq = lane >> 4;
  const int nt = K / BK;
  unsigned voff[2];
#pragma unroll
  for (int i = 0; i < 2; ++i) {
    int R, C;
    stage_rc(tid * 16 + i * 8192, R, C);
    voff[i] = (unsigned)(R * K + C) * 2u;
  }
  const size_t kstep = (size_t)(BK * 2);
  const size_t hstep = (size_t)HALF * K * 2;
  const size_t tstep = 2 * hstep;
  const unsigned ldsw = (unsigned)wid * 1024u;
  const int aoff = lds_byte(wr * 64 + fr, fq * 8), boff = lds_byte(wc * 32 + fr, fq * 8);
#define G_SA(b, h) (((b)*2 + (h)) * HTB)
#define G_SB(b, h) ((4 + (b)*2 + (h)) * HTB)
#define G_STAGE(bufoff, gbase)                                                                                          \
  do {                                                                                                                  \
    _Pragma("unroll") for (int _i = 0; _i < 2; ++_i) __builtin_amdgcn_global_load_lds(                                  \
        (const unsigned*)((const char*)(gbase) + voff[_i]), (LAS unsigned*)(lds + (bufoff) + ldsw + _i * 8192), 16, 0, 0); \
  } while (0)
#define G_LDA(dst, b, h)                                                                                                \
  do {                                                                                                                  \
    _Pragma("unroll") for (int m = 0; m < 4; ++m) _Pragma("unroll") for (int k = 0; k < 2; ++k) dst[m][k] =             \
        *(const LAS bf16x8*)(lds + G_SA(b, h) + aoff + m * 2048 + k * 1024);                                            \
  } while (0)
#define G_LDB(dst, b, h)                                                                                                \
  do {                                                                                                                  \
    _Pragma("unroll") for (int n = 0; n < 2; ++n) _Pragma("unroll") for (int k = 0; k < 2; ++k) dst[n][k] =             \
        *(const LAS bf16x8*)(lds + G_SB(b, h) + boff + n * 2048 + k * 1024);                                            \
  } while (0)
#define G_MMA(ai, bj, At, Bq)                                                                                           \
  do {                                                                                                                  \
    __builtin_amdgcn_s_setprio(1);                                                                                      \
    _Pragma("unroll") for (int m = 0; m < 4; ++m) _Pragma("unroll") for (int n = 0; n < 2; ++n) _Pragma("unroll") for ( \
        int k = 0; k < 2; ++k) acc[ai][bj][m][n] =                                                                      \
        __builtin_amdgcn_mfma_f32_16x16x32_bf16(Bq[n][k], At[m][k], acc[ai][bj][m][n], 0, 0, 0);                        \
    __builtin_amdgcn_s_setprio(0);                                                                                      \
  } while (0)
#define G_WAIT_V(n) asm volatile("s_waitcnt vmcnt(" #n ")" ::: "memory")
#define G_WAIT_L(n) asm volatile("s_waitcnt lgkmcnt(" #n ")" ::: "memory")
#define G_BAR __builtin_amdgcn_s_barrier()
#define G_SCHED __builtin_amdgcn_sched_barrier(0)
  Order S;
  S.init(M, N, offshift);
  Unit cur, nxt;
  int ui = 0;
  if (S.next(0, cur)) {
    f32x4 acc[2][2][4][2];
#pragma unroll
    for (int a = 0; a < 2; ++a)
#pragma unroll
      for (int b = 0; b < 2; ++b)
#pragma unroll
        for (int m = 0; m < 4; ++m)
#pragma unroll
          for (int n = 0; n < 2; ++n) acc[a][b][m][n] = (f32x4){0.f, 0.f, 0.f, 0.f};
    bf16x8 At[4][2], B0[2][2], B1[2][2];
    const char* cA = (const char*)Ag + (size_t)cur.pm * tstep;
    const char* cB = (const char*)Btg + (size_t)cur.pn * tstep;
    float rs_pre[2][4];
#define G_PRELOAD_RS(UU)                                                                                          \
  if constexpr (EPI == EPI_SWIGLU || EPI == EPI_PLEGATE) {                                                        \
    _Pragma("unroll") for (int ai_ = 0; ai_ < 2; ++ai_) _Pragma("unroll") for (int m_ = 0; m_ < 4; ++m_)         \
        rs_pre[ai_][m_] = ea.ss_in[(UU).pm * 256 + wr * 64 + fr + ai_ * 128 + m_ * 16];                           \
  } else {                                                                                                        \
    _Pragma("unroll") for (int ai_ = 0; ai_ < 2; ++ai_) _Pragma("unroll") for (int m_ = 0; m_ < 4; ++m_) rs_pre[ai_][m_] = 0.f; \
  }
    G_PRELOAD_RS(cur);
    G_STAGE(G_SB(0, 0), cB); G_STAGE(G_SA(0, 0), cA); G_STAGE(G_SB(0, 1), cB + hstep); G_STAGE(G_SA(0, 1), cA + hstep);
    if (wr == 1) G_BAR;
    G_WAIT_V(4); G_BAR;
    G_STAGE(G_SB(1, 0), cB + kstep); G_STAGE(G_SA(1, 0), cA + kstep); G_STAGE(G_SB(1, 1), cB + hstep + kstep);
    G_WAIT_V(6); G_BAR;
    for (;;) {
      const bool has_next = S.next(ui + 1, nxt);
      const char* nA = has_next ? (const char*)Ag + (size_t)nxt.pm * tstep : cA;
      const char* nB = has_next ? (const char*)Btg + (size_t)nxt.pn * tstep : cB;
      for (int t = 0; t < nt; t += 2) {
        const bool last = (t == nt - 2);
        const char* a1 = cA + (size_t)(t + 1) * kstep;
        const char* a2 = last ? nA : cA + (size_t)(t + 2) * kstep;
        const char* b2 = last ? nB : cB + (size_t)(t + 2) * kstep;
        const char* a3 = a2 + kstep;
        const char* b3 = b2 + kstep;
        G_LDB(B0, 0, 0); G_SCHED; G_LDA(At, 0, 0); G_STAGE(G_SA(1, 1), a1 + hstep);
        G_WAIT_L(8); G_BAR; G_WAIT_L(0); G_MMA(0, 0, At, B0); G_BAR; G_SCHED;
        G_LDB(B1, 0, 1); G_STAGE(G_SB(0, 0), b2);
        G_BAR; G_WAIT_L(0); G_MMA(0, 1, At, B1); G_BAR;
        G_LDA(At, 0, 1); G_STAGE(G_SA(0, 0), a2);
        G_BAR; G_WAIT_L(0); G_MMA(1, 0, At, B0); G_BAR; G_SCHED;
        G_STAGE(G_SB(0, 1), b2 + hstep);
        G_WAIT_V(6); G_BAR; G_MMA(1, 1, At, B1); G_BAR;
        G_LDB(B0, 1, 0); G_SCHED; G_LDA(At, 1, 0); G_STAGE(G_SA(0, 1), a2 + hstep);
        G_WAIT_L(8); G_BAR; G_WAIT_L(0); G_MMA(0, 0, At, B0); G_BAR; G_SCHED;
        G_LDB(B1, 1, 1); G_STAGE(G_SB(1, 0), b3);
        G_BAR; G_WAIT_L(0); G_MMA(0, 1, At, B1); G_BAR;
        G_LDA(At, 1, 1); G_STAGE(G_SA(1, 0), a3);
        G_BAR; G_WAIT_L(0); G_MMA(1, 0, At, B0); G_BAR; G_SCHED;
        G_STAGE(G_SB(1, 1), b3 + hstep);
        G_WAIT_V(6); G_BAR; G_MMA(1, 1, At, B1); G_BAR;
      }
      gemm_epilogue<EPI>(acc, cur, wr, wc, fr, fq, ea, rs_pre);
      if (!has_next) break;
#pragma unroll
      for (int a = 0; a < 2; ++a)
#pragma unroll
        for (int b = 0; b < 2; ++b)
#pragma unroll
          for (int m = 0; m < 4; ++m)
#pragma unroll
            for (int n = 0; n < 2; ++n) acc[a][b][m][n] = (f32x4){0.f, 0.f, 0.f, 0.f};
      cur = nxt; cA = nA; cB = nB; ++ui;
      G_PRELOAD_RS(cur);
    }
    G_WAIT_V(0);
    if (wr == 0) G_BAR;
    G_BAR;
  }
  __syncthreads();
#undef G_PRELOAD_RS
#undef G_SA
#undef G_SB
#undef G_STAGE
#undef G_LDA
#undef G_LDB
#undef G_MMA
#undef G_WAIT_V
#undef G_WAIT_L
#undef G_BAR
#undef G_SCHED
}

__device__ __forceinline__ f32x16 mfma32(bf16x8 a, bf16x8 b, f32x16 c) {
  return __builtin_amdgcn_mfma_f32_32x32x16_bf16(a, b, c, 0, 0, 0);
}

template <bool FOX>
__device__ __forceinline__ void attn_wave(const u16* __restrict__ Qb, int ldq, const u16* __restrict__ Kb, int ldk,
                                          const u16* __restrict__ Vt, const float* __restrict__ c2n, float sink2, int q0,
                                          u16* __restrict__ Yb, int ldy) {
  const int lane = lane_id_v();
  const int ln = lane & 31, hh = lane >> 5;
  bf16x8 bq[2][4];
#pragma unroll
  for (int qt = 0; qt < 2; ++qt)
#pragma unroll
    for (int kk = 0; kk < 4; ++kk)
      bq[qt][kk] = *reinterpret_cast<const bf16x8*>(Qb + (size_t)(q0 + qt * 32 + ln) * ldq + kk * 16 + hh * 8);
  f32x16 o[2][2];
#pragma unroll
  for (int a = 0; a < 2; ++a)
#pragma unroll
    for (int b = 0; b < 2; ++b)
#pragma unroll
      for (int r = 0; r < 16; ++r) o[a][b][r] = 0.f;
  float mrun[2], lrun[2];
  mrun[0] = mrun[1] = FOX ? -1e30f : sink2;
  lrun[0] = lrun[1] = FOX ? 0.f : (hh == 0 ? 1.f : 0.f);
  const int kt0 = FOX ? 0 : (max(0, q0 - 128) >> 5), kt1 = (q0 + 64) >> 5;
  bf16x8 ak[4];
  f32x16 negc;
  const u16* kp = Kb + (size_t)kt0 * 2048 + lane * 8;
  const u16* vp = Vt + (size_t)kt0 * 2048 + lane * 8;
  const float* cp = c2n + kt0 * 32 + 4 * hh;
#pragma unroll
  for (int kk = 0; kk < 4; ++kk) ak[kk] = *reinterpret_cast<const bf16x8*>(kp + kk * 512);
  if (FOX) {
#pragma unroll
    for (int jj = 0; jj < 4; ++jj) {
      f32x4 cv = *reinterpret_cast<const f32x4*>(cp + 8 * jj);
      negc[4 * jj + 0] = cv[0]; negc[4 * jj + 1] = cv[1]; negc[4 * jj + 2] = cv[2]; negc[4 * jj + 3] = cv[3];
    }
  } else {
#pragma unroll
    for (int r = 0; r < 16; ++r) negc[r] = 0.f;
  }
  for (int kt = kt0; kt < kt1; ++kt) {
    const int k0 = kt * 32;
    bf16x8 av[2][2];
#pragma unroll
    for (int dt = 0; dt < 2; ++dt)
#pragma unroll
      for (int ks = 0; ks < 2; ++ks) av[dt][ks] = *reinterpret_cast<const bf16x8*>(vp + (dt * 2 + ks) * 512);
    f32x16 st[2];
#pragma unroll
    for (int qt = 0; qt < 2; ++qt) {
      st[qt] = mfma32(ak[0], bq[qt][0], negc);
#pragma unroll
      for (int kk = 1; kk < 4; ++kk) st[qt] = mfma32(ak[kk], bq[qt][kk], st[qt]);
    }
    kp += 2048;
    vp += 2048;
    cp += 32;
    if (kt + 1 < kt1) {
#pragma unroll
      for (int kk = 0; kk < 4; ++kk) ak[kk] = *reinterpret_cast<const bf16x8*>(kp + kk * 512);
      if (FOX) {
#pragma unroll
        for (int jj = 0; jj < 4; ++jj) {
          f32x4 cv = *reinterpret_cast<const f32x4*>(cp + 8 * jj);
          negc[4 * jj + 0] = cv[0]; negc[4 * jj + 1] = cv[1]; negc[4 * jj + 2] = cv[2]; negc[4 * jj + 3] = cv[3];
        }
      }
    }
    const bool needmask = FOX ? (k0 + 31 > q0) : true;
    if (needmask) {
#pragma unroll
      for (int qt = 0; qt < 2; ++qt) {
        int qpos = q0 + qt * 32 + ln;
#pragma unroll
        for (int r = 0; r < 16; ++r) {
          int kpos = k0 + 8 * (r >> 2) + 4 * hh + (r & 3);
          bool bad = kpos > qpos;
          if (!FOX) bad = bad || (qpos - kpos >= 128);
          st[qt][r] = bad ? -1e30f : st[qt][r];
        }
      }
    }
    bf16x8 bp[2][2];
#pragma unroll
    for (int qt = 0; qt < 2; ++qt) {
      float mx = fmaxf(fmaxf(st[qt][0], st[qt][1]), fmaxf(st[qt][2], st[qt][3]));
#pragma unroll
      for (int r = 4; r < 16; r += 4) mx = fmaxf(fmaxf(mx, st[qt][r]), fmaxf(fmaxf(st[qt][r + 1], st[qt][r + 2]), st[qt][r + 3]));
      mx = xmax32(mx);
      const float mnew = fmaxf(mrun[qt], mx);
      const float alpha = ex2(mrun[qt] - mnew);
      mrun[qt] = mnew;
      float ps0 = 0.f, ps1 = 0.f;
#pragma unroll
      for (int r = 0; r < 16; r += 2) {
        float p0 = ex2(st[qt][r] - mnew), p1 = ex2(st[qt][r + 1] - mnew);
        ps0 += p0; ps1 += p1;
        st[qt][r] = p0; st[qt][r + 1] = p1;
      }
      lrun[qt] = lrun[qt] * alpha + (ps0 + ps1);
#pragma unroll
      for (int dt = 0; dt < 2; ++dt) o[dt][qt] = o[dt][qt] * alpha;
#pragma unroll
      for (int ks = 0; ks < 2; ++ks) {
        union { bf16x8 v; uint32_t w[4]; } u;
#pragma unroll
        for (int e = 0; e < 4; ++e) u.w[e] = pack2(st[qt][8 * ks + 2 * e], st[qt][8 * ks + 2 * e + 1]);
        bp[qt][ks] = u.v;
      }
    }
#pragma unroll
    for (int dt = 0; dt < 2; ++dt)
#pragma unroll
      for (int qt = 0; qt < 2; ++qt)
#pragma unroll
        for (int ks = 0; ks < 2; ++ks) o[dt][qt] = mfma32(av[dt][ks], bp[qt][ks], o[dt][qt]);
  }
#pragma unroll
  for (int qt = 0; qt < 2; ++qt) {
    float lt = xsum32(lrun[qt]);
    float inv = 1.f / lt;
    u16* yp = Yb + (size_t)(q0 + qt * 32 + ln) * ldy;
#pragma unroll
    for (int dt = 0; dt < 2; ++dt)
#pragma unroll
      for (int jj = 0; jj < 4; ++jj) {
        uint2 pk;
        pk.x = pack2(o[dt][qt][4 * jj + 0] * inv, o[dt][qt][4 * jj + 1] * inv);
        pk.y = pack2(o[dt][qt][4 * jj + 2] * inv, o[dt][qt][4 * jj + 3] * inv);
        *reinterpret_cast<uint2*>(yp + dt * 32 + 8 * jj + 4 * hh) = pk;
      }
  }
}

template <bool FINAL>
__device__ __forceinline__ void lru_job(const Params& P, int j, int b, int chunk, int h, char* ldsw) {
  const int lane = lane_id_v();
  const int ln = lane & 31, hh = lane >> 5;
  const int ch = h * 64 + lane;
  float* rbuf = reinterpret_cast<float*>(ldsw);
  float* ibuf = reinterpret_cast<float*>(ldsw + 8192);
  u16* xcb = reinterpret_cast<u16*>(ldsw + 8192);
  const float* cw = P.in[I_CONVW] + (size_t)j * 4 * 512;
  const float cw0 = cw[ch], cw1 = cw[512 + ch], cw2 = cw[1024 + ch], cw3 = cw[1536 + ch];
  const float cb = P.in[I_CONVB][j * 512 + ch];
  const float ba = P.in[I_BA][j * 512 + ch], bx = P.in[I_BX][j * 512 + ch];
  const float lam = P.in[I_LAM][j * 512 + ch];
  const float sp = fmaxf(lam, 0.f) + log1pf(__expf(-fabsf(lam)));
  const u16* lruw = reinterpret_cast<const u16*>(P.ws + OFF_W_LRU);
  const u16* wat = lruw + (size_t)((j * 2 + 0) * 8 + h) * 4096;
  const u16* wxt = lruw + (size_t)((j * 2 + 1) * 8 + h) * 4096;
  const u16* Z = reinterpret_cast<const u16*>(P.ws + OFF_BIG);
  const u16* xap = Z + (size_t)(b * 4096) * 1536 + ch;
  u16* Y = reinterpret_cast<u16*>(P.ws + OFF_BUFY);
  float* agg = reinterpret_cast<float*>(P.ws + OFF_LRUAGG);
  const int t0 = chunk * 64;
  float w0 = 0.f, w1 = 0.f, w2 = 0.f;
  if (t0 > 0) {
    w0 = bf2f(xap[(size_t)(t0 - 3) * 1536]);
    w1 = bf2f(xap[(size_t)(t0 - 2) * 1536]);
    w2 = bf2f(xap[(size_t)(t0 - 1) * 1536]);
  }
  float v0 = w0, v1 = w1, v2 = w2;
  float hst = 0.f, Ap = 1.f;
  if (FINAL) {
    const float2* ap = reinterpret_cast<const float2*>(agg) + (size_t)(b * 64) * 512 + ch;
    int c = 0;
    for (; c + 8 <= chunk; c += 8) {
      float2 ab[8];
#pragma unroll
      for (int q = 0; q < 8; ++q) ab[q] = ap[(size_t)(c + q) * 512];
#pragma unroll
      for (int q = 0; q < 8; ++q) hst = ab[q].x * hst + ab[q].y;
    }
    for (; c < chunk; ++c) {
      float2 ab = ap[(size_t)c * 512];
      hst = ab.x * hst + ab.y;
    }
  }
  for (int sub = 0; sub < 2; ++sub) {
    const u16* xs = xap + (size_t)(t0 + sub * 32) * 1536;
#pragma unroll 16
    for (int tt = 0; tt < 32; ++tt) {
      float xt = bf2f(xs[(size_t)tt * 1536]);
      float v = cb + w0 * cw0 + w1 * cw1 + w2 * cw2 + xt * cw3;
      xcb[tt * 72 + lane] = f2bf(v);
      w0 = w1; w1 = w2; w2 = xt;
    }
    f32x16 ar0, ar1, ai0, ai1;
#pragma unroll
    for (int nt = 0; nt < 2; ++nt) {
      f32x16 ar, ai;
#pragma unroll
      for (int r = 0; r < 16; ++r) { ar[r] = 0.f; ai[r] = 0.f; }
#pragma unroll
      for (int kk = 0; kk < 4; ++kk) {
        bf16x8 a = *reinterpret_cast<const bf16x8*>(xcb + ln * 72 + kk * 16 + hh * 8);
        bf16x8 ba_ = *reinterpret_cast<const bf16x8*>(wat + (nt * 32 + ln) * 64 + kk * 16 + hh * 8);
        bf16x8 bx_ = *reinterpret_cast<const bf16x8*>(wxt + (nt * 32 + ln) * 64 + kk * 16 + hh * 8);
        ar = mfma32(a, ba_, ar);
        ai = mfma32(a, bx_, ai);
      }
      if (nt == 0) { ar0 = ar; ai0 = ai; } else { ar1 = ar; ai1 = ai; }
    }
#pragma unroll
    for (int r = 0; r < 16; ++r) {
      int trow = 8 * (r >> 2) + 4 * hh + (r & 3);
      rbuf[trow * 64 + ln] = ar0[r];
      rbuf[trow * 64 + 32 + ln] = ar1[r];
      ibuf[trow * 64 + ln] = ai0[r];
      ibuf[trow * 64 + 32 + ln] = ai1[r];
    }
    const size_t rowb = (size_t)b * 4096 + t0 + sub * 32;
    float xq[4], yq[4], xqn[4], yqn[4];
#pragma unroll
    for (int q = 0; q < 4; ++q) {
      xq[q] = bf2f(xs[(size_t)q * 1536]);
      yq[q] = FINAL ? bf2f(Z[(rowb + q) * 1536 + 512 + ch]) : 0.f;
    }
    for (int tg = 0; tg < 32; tg += 4) {
      if (tg + 4 < 32) {
#pragma unroll
        for (int q = 0; q < 4; ++q) {
          xqn[q] = bf2f(xs[(size_t)(tg + 4 + q) * 1536]);
          yqn[q] = FINAL ? bf2f(Z[(rowb + tg + 4 + q) * 1536 + 512 + ch]) : 0.f;
        }
      }
#pragma unroll
      for (int q = 0; q < 4; ++q) {
        const int tt = tg + q;
        const float xt = xq[q];
        float xcv = cb + v0 * cw0 + v1 * cw1 + v2 * cw2 + xt * cw3;
        v0 = v1; v1 = v2; v2 = xt;
        float rr = sigmoidf_(rbuf[tt * 64 + lane] + ba);
        float ii = sigmoidf_(ibuf[tt * 64 + lane] + bx);
        float la = -8.f * rr * sp;
        float a = __expf(la);
        const float x2 = 2.f * la;
        const float om = (x2 > -0.03f) ? -x2 * (1.f + x2 * (0.5f + x2 * (0.16666667f + x2 * 0.041666667f))) : 1.f - a * a;
        float bc = __builtin_amdgcn_sqrtf(om);
        hst = a * hst + bc * ii * xcv;
        if (FINAL) {
          Y[(rowb + tt) * 1024 + ch] = f2bf(hst * gelu_tanh(yq[q]));
        } else {
          Ap *= a;
        }
      }
#pragma unroll
      for (int q = 0; q < 4; ++q) { xq[q] = xqn[q]; yq[q] = yqn[q]; }
    }
  }
  if (!FINAL) {
    *reinterpret_cast<float2*>(agg + ((size_t)(b * 64 + chunk) * 512 + ch) * 2) = make_float2(Ap, hst);
  }
}

template <bool FINAL>
__device__ __forceinline__ void s5_wave(const Params& P, int j, int g, int idx0, int stride, char* ldsw) {
  const int lane = lane_id_v();
  const int p = lane;
  const int jg = j * 32 + g;
  const float lr = P.in[I_S5LRE][jg * 64 + p], li = P.in[I_S5LIM][jg * 64 + p];
  const float dt = expf(P.in[I_S5LOGDT][jg]);
  const float er = expf(lr * dt);
  float sn, cs;
  sincosf(li * dt, &sn, &cs);
  const float lbr = er * cs, lbi = er * sn;
  const float nr = lbr - 1.f, ni = lbi;
  const float den = 1.f / (lr * lr + li * li);
  const float cr = (nr * lr + ni * li) * den, ci = (ni * lr - nr * li) * den;
  typedef float f32x2 __attribute__((ext_vector_type(2)));
  f32x2 bb[16];
  {
    const float4* br4 = reinterpret_cast<const float4*>(P.in[I_S5BRE] + ((size_t)jg * 64 + p) * 16);
    const float4* bi4 = reinterpret_cast<const float4*>(P.in[I_S5BIM] + ((size_t)jg * 64 + p) * 16);
#pragma unroll
    for (int q = 0; q < 4; ++q) {
      float4 a = br4[q], c = bi4[q];
      bb[4 * q + 0] = (f32x2){cr * a.x - ci * c.x, cr * c.x + ci * a.x};
      bb[4 * q + 1] = (f32x2){cr * a.y - ci * c.y, cr * c.y + ci * a.y};
      bb[4 * q + 2] = (f32x2){cr * a.z - ci * c.z, cr * c.z + ci * a.z};
      bb[4 * q + 3] = (f32x2){cr * a.w - ci * c.w, cr * c.w + ci * a.w};
    }
  }
  const u16* Zo = reinterpret_cast<const u16*>(P.ws + OFF_BIG);
  float2* hend = reinterpret_cast<float2*>(P.ws + OFF_S5END);
  uint32_t* hbuf = reinterpret_cast<uint32_t*>(ldsw);
  float pr = lbr, pi = lbi;
#pragma unroll
  for (int s6 = 0; s6 < 6; ++s6) {
    float nr2 = pr * pr - pi * pi, ni2 = 2.f * pr * pi;
    pr = nr2; pi = ni2;
  }
  const int fr = lane & 15, fq = lane >> 4;
  bf16x8 bc[4];
  f32x4 dv4 = {0.f, 0.f, 0.f, 0.f};
  if (FINAL) {
    const float* crp = P.in[I_S5CRE] + ((size_t)jg * 16 + fr) * 64;
    const float* cip = P.in[I_S5CIM] + ((size_t)jg * 16 + fr) * 64;
#pragma unroll
    for (int ks = 0; ks < 4; ++ks) {
      float4 a = *reinterpret_cast<const float4*>(crp + ks * 16 + fq * 4);
      float4 c = *reinterpret_cast<const float4*>(cip + ks * 16 + fq * 4);
      union { bf16x8 v; uint32_t w[4]; } uu_;
      uu_.w[0] = pack2(a.x, -c.x); uu_.w[1] = pack2(a.y, -c.y); uu_.w[2] = pack2(a.z, -c.z); uu_.w[3] = pack2(a.w, -c.w);
      bc[ks] = uu_.v;
    }
    dv4 = *reinterpret_cast<const f32x4*>(P.in[I_S5D] + j * 512 + g * 16 + 4 * fq);
  }
  for (int idx = idx0; idx < 16384; idx += stride) {
  const int b = idx >> 11, chunk = ((idx >> 5) + 8 * b) & 63;
  const size_t rowbase = (size_t)b * 4096 + chunk * 64;
  const u16* up = Zo + (rowbase + lane) * 1280 + 768 + g * 16;
  const uint4 u0 = *reinterpret_cast<const uint4*>(up);
  const uint4 u1 = *reinterpret_cast<const uint4*>(up + 8);
  float hr = 0.f, hi = 0.f;
  if (FINAL) {
    const float2* hp = hend + ((size_t)(b * 64) * 32 + g) * 64 + p;
    int c = 0;
    for (; c + 8 <= chunk; c += 8) {
      float2 e[8];
#pragma unroll
      for (int q = 0; q < 8; ++q) e[q] = hp[(size_t)(c + q) * 2048];
#pragma unroll
      for (int q = 0; q < 8; ++q) {
        float t_r = pr * hr - pi * hi + e[q].x;
        float t_i = pr * hi + pi * hr + e[q].y;
        hr = t_r; hi = t_i;
      }
    }
    for (; c < chunk; ++c) {
      float2 e = hp[(size_t)c * 2048];
      float t_r = pr * hr - pi * hi + e.x;
      float t_i = pr * hi + pi * hr + e.y;
      hr = t_r; hi = t_i;
    }
  }
#pragma unroll 2
  for (int t = 0; t < 64; ++t) {
    uint32_t w[8];
    w[0] = __builtin_amdgcn_readlane(u0.x, t); w[1] = __builtin_amdgcn_readlane(u0.y, t);
    w[2] = __builtin_amdgcn_readlane(u0.z, t); w[3] = __builtin_amdgcn_readlane(u0.w, t);
    w[4] = __builtin_amdgcn_readlane(u1.x, t); w[5] = __builtin_amdgcn_readlane(u1.y, t);
    w[6] = __builtin_amdgcn_readlane(u1.z, t); w[7] = __builtin_amdgcn_readlane(u1.w, t);
    f32x2 acc0 = (f32x2){lbr * hr - lbi * hi, lbr * hi + lbi * hr}, acc1 = (f32x2){0.f, 0.f};
#pragma unroll
    for (int q = 0; q < 8; ++q) {
      float ua = __uint_as_float(w[q] << 16), ub = __uint_as_float(w[q] & 0xffff0000u);
      acc0 = bb[2 * q] * (f32x2){ua, ua} + acc0;
      acc1 = bb[2 * q + 1] * (f32x2){ub, ub} + acc1;
    }
    acc0 = acc0 + acc1;
    hr = acc0.x; hi = acc0.y;
    if (FINAL) hbuf[t * 68 + p] = pack2(hr, hi);
  }
  if (!FINAL) {
    hend[((size_t)(b * 64 + chunk) * 32 + g) * 64 + p] = make_float2(hr, hi);
  } else {
    u16* zs = reinterpret_cast<u16*>(P.ws + OFF_BIG + (size_t)T * 1280 * 2);
    uint2 uw[4];
#pragma unroll
    for (int mt = 0; mt < 4; ++mt)
      uw[mt] = *reinterpret_cast<const uint2*>(Zo + (rowbase + mt * 16 + fr) * 1280 + 768 + g * 16 + 4 * fq);
#pragma unroll
    for (int mt = 0; mt < 4; ++mt) {
      f32x4 y = {0.f, 0.f, 0.f, 0.f};
#pragma unroll
      for (int ks = 0; ks < 4; ++ks) {
        bf16x8 a = *reinterpret_cast<const bf16x8*>(hbuf + (mt * 16 + fr) * 68 + ks * 16 + fq * 4);
        y = __builtin_amdgcn_mfma_f32_16x16x32_bf16(bc[ks], a, y, 0, 0, 0);
      }
      const float uvf[4] = {__uint_as_float(uw[mt].x << 16), __uint_as_float(uw[mt].x & 0xffff0000u),
                            __uint_as_float(uw[mt].y << 16), __uint_as_float(uw[mt].y & 0xffff0000u)};
      f32x4 zo;
#pragma unroll
      for (int i = 0; i < 4; ++i) zo[i] = gelu_tanh(y[i] + dv4[i] * uvf[i]);
      *reinterpret_cast<uint2*>(zs + (rowbase + mt * 16 + fr) * 512 + g * 16 + 4 * fq) = pack4(zo);
    }
  }
  }
}

#define XB_TMO 128
#define XB_XCNT(j) (256 + 64 * (j))
#define XB_XSUB(j) (1280 + 64 * (j))
#define XB_XGEN(j) (2304 + 64 * (j))
#define XB_TOP 3328
#define XB_TOPGEN 3392
#define XCD_BAR_WORDS 3456
#define XB_SPIN_CAP (1u << 20)
__device__ __forceinline__ unsigned xb_ld(unsigned* p) { return __hip_atomic_load(p, __ATOMIC_RELAXED, __HIP_MEMORY_SCOPE_AGENT); }
__device__ __forceinline__ unsigned xb_add(unsigned* p, unsigned v) { return __hip_atomic_fetch_add(p, v, __ATOMIC_RELAXED, __HIP_MEMORY_SCOPE_AGENT); }
__device__ __forceinline__ unsigned xb_xcc_id() { return (unsigned)__builtin_amdgcn_s_getreg((3 << 11) | 20) & 0xFu; }
#define XB_SPIN(cond, bar)                                                  \
  do {                                                                      \
    unsigned _sp = 0;                                                       \
    while (cond) {                                                          \
      __builtin_amdgcn_s_sleep(1);                                          \
      if ((++_sp & 255u) == 0u) {                                           \
        if (xb_ld(&(bar)[XB_TMO])) break;                                   \
        if (_sp > XB_SPIN_CAP) { atomicAdd(&(bar)[XB_TMO], 1u); break; }    \
      }                                                                     \
    }                                                                       \
  } while (0)

__device__ __forceinline__ void xcd_barrier_complete(unsigned* bar, unsigned x, unsigned& nloc, unsigned& nx) {
  const unsigned G = gridDim.x;
  unsigned sum, cnt, mine, sp = 0u;
  for (;;) {
    sum = 0u; cnt = 0u; mine = 0u;
#pragma unroll
    for (unsigned j = 0; j < 16; ++j) {
      const unsigned c = xb_ld(&bar[XB_XCNT(j)]);
      sum += c; cnt += (c > 0u) ? 1u : 0u; mine = (j == x) ? c : mine;
    }
    if (sum == G) break;
    __builtin_amdgcn_s_sleep(1);
    if ((++sp & 255u) == 0u) {
      if (xb_ld(&bar[XB_TMO])) break;
      if (sp > XB_SPIN_CAP) { atomicAdd(&bar[XB_TMO], 1u); break; }
    }
  }
  nloc = mine > 0u ? mine : 1u;
  nx = cnt > 0u ? cnt : 1u;
}

__device__ __forceinline__ void xcd_barrier(unsigned* bar, volatile LAS unsigned* st, bool leader_thread) {
  asm volatile("s_waitcnt vmcnt(0)" ::: "memory");
  __syncthreads();
  if (leader_thread) {
    const unsigned x = xb_xcc_id();
    __builtin_amdgcn_s_waitcnt(0);
    unsigned nloc = st[0], nx = st[1];
    if (nloc == 0u) { xcd_barrier_complete(bar, x, nloc, nx); st[0] = nloc; st[1] = nx; }
    const unsigned old = xb_add(&bar[XB_XSUB(x)], 1u);
    const unsigned gen = old / nloc;
    if (old + 1u == (gen + 1u) * nloc) {
      __builtin_amdgcn_fence(__ATOMIC_RELEASE, "agent");
      asm volatile("s_waitcnt vmcnt(0)" ::: "memory");
      const unsigned og = xb_add(&bar[XB_TOP], 1u);
      const unsigned tg = og / nx;
      if (og + 1u == (tg + 1u) * nx) xb_add(&bar[XB_TOPGEN], 1u);
      else XB_SPIN(xb_ld(&bar[XB_TOPGEN]) == tg, bar);
      __builtin_amdgcn_fence(__ATOMIC_ACQUIRE, "agent");
      xb_add(&bar[XB_XGEN(x)], 1u);
      asm volatile("s_waitcnt vmcnt(0)" ::: "memory");
    } else {
      XB_SPIN(xb_ld(&bar[XB_XGEN(x)]) == gen, bar);
      __builtin_amdgcn_fence(__ATOMIC_ACQUIRE, "agent");
      asm volatile("s_waitcnt vmcnt(0)" ::: "memory");
    }
  }
  __syncthreads();
}

enum { K_G1, K_G2, K_G3, K_M1, K_M2, K_M3, K_G4, K_G5, K_G6, K_G7, K_NUM };
enum { C_P0, C_SWIGLU, C_RESID, C_G3, C_M1, C_M2, C_M3, C_G7 };

template <int CLS>
__device__ __forceinline__ void run_phase(const Params& P, int l, int kind_in, const int wid) {
  int kind = kind_in;
  extern __shared__ __attribute__((aligned(16))) char shm_raw[];
  const int lane = lane_id_v(), tid = wid * 64 + lane;
  const int gw = blockIdx.x * 8 + wid, nw = gridDim.x * 8;
  const int gt = blockIdx.x * 512 + tid, ntot = gridDim.x * 512;
  char* ws = P.ws;
  u16* bufX = reinterpret_cast<u16*>(ws + OFF_BUFX);
  u16* bufY = reinterpret_cast<u16*>(ws + OFF_BUFY);
  u16* pe = reinterpret_cast<u16*>(ws + OFF_PE);
  u16* pbf = reinterpret_cast<u16*>(ws + OFF_PBF);
  u16* big = reinterpret_cast<u16*>(ws + OFF_BIG);
  float* ss = reinterpret_cast<float*>(ws + OFF_SS);
  float* sspe = reinterpret_cast<float*>(ws + OFF_SSPE);
  float* flog = reinterpret_cast<float*>(ws + OFF_FLOG);
  float* c2 = reinterpret_cast<float*>(ws + OFF_C2);
  float2* rope = reinterpret_cast<float2*>(ws + OFF_ROPE);
  char* ldsw = shm_raw + wid * LDS_WAVE;
  const bool dup = (kind & 64) != 0;
  kind &= 63;
  const bool even = (l & 1) == 0;
  const int j = l >> 1;
  EpiArgs ea{};
  (void)dup;
  (void)gw; (void)nw; (void)gt; (void)ntot; (void)lane; (void)bufX; (void)bufY; (void)pe; (void)pbf; (void)big; (void)ss;
  (void)sspe; (void)flog; (void)c2; (void)rope; (void)ldsw; (void)even; (void)j;
  if constexpr (CLS == C_P0) {
  {
    float* tile = reinterpret_cast<float*>(shm_raw);
    for (int g = blockIdx.x; g < TL_TOTAL; g += gridDim.x) {
      const TDesc d = weight_tile_desc(P, g);
      transpose_tile(d, tile, tid);
    }
    {
      u16* lruw = reinterpret_cast<u16*>(ws + OFF_W_LRU);
      for (int e = gt; e < 2 * 2 * 8 * 4096; e += ntot) {
        int i = e & 63, jc = (e >> 6) & 63, h = (e >> 12) & 7, m = (e >> 15) & 1, j = e >> 16;
        const float* src = (m ? P.in[I_WX] : P.in[I_WA]) + ((size_t)(j * 8 + h) * 64 + i) * 64 + jc;
        lruw[e] = f2bf(*src);
      }
    }
    for (int e = gt; e < 4096 * 32; e += ntot) {
      int pos = e >> 5, d = e & 31;
      float inv = powf(10000.f, -(float)d / 32.f);
      float ang = (float)pos * inv;
      float s, c;
      sincosf(ang, &s, &c);
      rope[e] = make_float2(c, s);
    }
    for (int e = gt; e < 20 * T; e += ntot) ss[T + e] = 0.f;
    for (int row = gw; row < T; row += nw) {
      const float4* xr = reinterpret_cast<const float4*>(P.in[I_X] + (size_t)row * 1024);
      float sq = 0.f;
#pragma unroll
      for (int q = 0; q < 2; ++q) {
        const int c8 = q * 64 + lane;
        const float4 v0 = xr[2 * c8], v1 = xr[2 * c8 + 1];
        sq += v0.x * v0.x + v0.y * v0.y + v0.z * v0.z + v0.w * v0.w + v1.x * v1.x + v1.y * v1.y + v1.z * v1.z + v1.w * v1.w;
        uint4 ph, pl;
        ph.x = pack2(v0.x, v0.y); ph.y = pack2(v0.z, v0.w); ph.z = pack2(v1.x, v1.y); ph.w = pack2(v1.z, v1.w);
        pl.x = pack2(v0.x - __uint_as_float(ph.x << 16), v0.y - __uint_as_float(ph.x & 0xffff0000u));
        pl.y = pack2(v0.z - __uint_as_float(ph.y << 16), v0.w - __uint_as_float(ph.y & 0xffff0000u));
        pl.z = pack2(v1.x - __uint_as_float(ph.z << 16), v1.y - __uint_as_float(ph.z & 0xffff0000u));
        pl.w = pack2(v1.z - __uint_as_float(ph.w << 16), v1.w - __uint_as_float(ph.w & 0xffff0000u));
        *reinterpret_cast<uint4*>(bufY + (size_t)row * 1024 + c8 * 8) = ph;
        *reinterpret_cast<uint4*>(reinterpret_cast<u16*>(P.out) + (size_t)row * 1024 + c8 * 8) = pl;
      }
#pragma unroll
      for (int o = 32; o >= 1; o >>= 1) sq += __shfl_xor(sq, o);
      if (lane == 0) ss[row] = sq;
    }
  }
  } else if constexpr (CLS == C_SWIGLU) {
          const bool first = kind == K_G1;
          ea.ss_in = ss + (size_t)(4 * l + (first ? 0 : 2)) * T;
          ea.out_bf = big;
          const u16* Aop = first ? bufY : bufX;
          const u16* W = reinterpret_cast<const u16*>(ws + (first ? OFF_W_F1GU : OFF_W_F2GU) + l * SZ_FFNGU);
          #ifndef NO_G_SWIGLU
          gemm_phase<EPI_SWIGLU>(Aop, W, T, 5632, 1024, ea, wid);
#endif
          } else if constexpr (CLS == C_RESID) {
          const u16* Aop;
          const u16* W;
          int K;
          if (kind == K_G4) {
            Aop = bufY;
            W = reinterpret_cast<const u16*>(ws + (even ? OFF_W_EVOUT : OFF_W_ODOUT) + (size_t)j * 1024 * 1024 * 2);
            K = 1024;
            ea.alpha = 1.f;
            ea.ss_out = ss + (size_t)(4 * l + 2) * T;
          } else {
            Aop = big;
            W = reinterpret_cast<const u16*>(ws + (kind == K_G2 ? OFF_W_F1D : OFF_W_F2D) + l * SZ_FFND);
            K = 2816;
            ea.alpha = 0.5f;
            ea.ss_out = ss + (size_t)(4 * l + (kind == K_G2 ? 1 : 3)) * T;
          }
          {
            u16* LO = reinterpret_cast<u16*>(P.out);
            ea.hi_in = (kind == K_G2) ? bufY : bufX;
            ea.lo_in = LO;
            ea.lo_out = (kind == K_G6 && l == 3) ? bufY : LO;
          }
          ea.xb_out = bufX;
          if (dup) { ea.alpha = 0.f; ea.ss_out = c2; }
#ifndef NO_G_RESID
          gemm_phase<EPI_RESID>(Aop, W, T, 1024, K, ea, wid);
#endif
          if (kind == K_G2 && !dup) {
            const float4* ps = reinterpret_cast<const float4*>(P.in[I_P] + (size_t)l * T * 256);
            for (int e = gt; e < T * 256 / 8; e += ntot) {
              const float4 v0 = ps[2 * e], v1 = ps[2 * e + 1];
              uint4 pk;
              pk.x = pack2(v0.x, v0.y); pk.y = pack2(v0.z, v0.w); pk.z = pack2(v1.x, v1.y); pk.w = pack2(v1.z, v1.w);
              reinterpret_cast<uint4*>(pbf)[e] = pk;
            }
          }
          } else if constexpr (CLS == C_G3) {
          ea.ss_in = ss + (size_t)(4 * l + 1) * T;
          ea.out_bf = big;
          EpiArgs ev{};
          ev.ss_in = ea.ss_in;
          if (even) {
            const u16* W = reinterpret_cast<const u16*>(ws + OFF_W_EVIN + (size_t)j * 2816 * 1024 * 2);
            ea.aux_f0 = P.in[I_FOXQN] + j * 64;
            ea.aux_f1 = P.in[I_FOXKN] + j * 64;
            ea.aux_f2 = P.in[I_FOXBF] + j * 8;
            ea.flog = flog;
            ea.kp = big + (size_t)T * 1536 + (size_t)64 * 64 * 4096;
            ea.nh = 8;
#ifndef NO_G_EVEN
            gemm_phase<EPI_EVEN>(bufX, W, T, 2304, 1024, ea, wid);
#endif
            ev.vt = big + (size_t)T * 1536;
            ev.nh = 8;
#ifndef NO_G_VT
            gemm_phase<EPI_VT>(W + (size_t)2304 * 1024, bufX, 512, T, 1024, ev, wid);
#endif
          } else {
            ea.aux_f0 = P.in[I_SWAQN] + j * 64;
            ea.aux_f1 = P.in[I_SWAKN] + j * 64;
            ea.aux_f2 = reinterpret_cast<const float*>(rope);
            ea.kp = big + (size_t)T * 1792 + (size_t)16 * 64 * 4096;
            ea.nh = 2;
#ifndef NO_G_ODD
            gemm_phase<EPI_ODD>(bufX, reinterpret_cast<const u16*>(ws + OFF_W_ODIN + (size_t)j * 1280 * 1024 * 2), T, 1280,
                                1024, ea, wid);
#endif
            ev.vt = big + (size_t)T * 1792;
            ev.nh = 2;
#ifndef NO_G_VT
            gemm_phase<EPI_VT>(reinterpret_cast<const u16*>(ws + OFF_W_ODV + (size_t)j * 256 * 1024 * 2), bufX, 256, T, 1024, ev, wid, 16);
#endif
          }
          EpiArgs eb{};
          eb.out_bf = pe;
          eb.aux_f1 = P.in[I_PLEN] + l * 1024;
          eb.ss_out = dup ? c2 : sspe + (size_t)l * T;
#ifndef NO_G_PE
          gemm_phase<EPI_PE>(pbf, reinterpret_cast<const u16*>(ws + OFF_W_PLE + (size_t)l * 1024 * 256 * 2), T, 1024, 256, eb, wid);
#endif
          } else if constexpr (CLS == C_M1) {
          if (even) {
#ifndef NO_LRU
            for (int idx = gw; idx < 4096; idx += nw) lru_job<false>(P, j, idx >> 9, (idx >> 3) & 63, idx & 7, ldsw);
#endif
            if (wid == 0 && blockIdx.x < 64) {
              int bh = blockIdx.x, b = bh >> 3, h = bh & 7;
              const float* fp = flog + ((size_t)b * 4096 + lane * 64) * 8 + h;
              float fv[64];
#pragma unroll
              for (int t = 0; t < 64; ++t) fv[t] = fp[t * 8];
              float s = 0.f;
#pragma unroll
              for (int t = 0; t < 64; ++t) s += fv[t];
              float inc = s;
#pragma unroll
              for (int o = 1; o < 64; o <<= 1) {
                float v = __shfl_up(inc, o);
                if (lane >= o) inc += v;
              }
              float run = inc - s;
              float* cp = c2 + (size_t)bh * 4096 + lane * 64;
#pragma unroll
              for (int t = 0; t < 64; t += 4) {
                f32x4 o4;
#pragma unroll
                for (int q = 0; q < 4; ++q) { run += fv[t + q]; o4[q] = -run * LOG2E; }
                *reinterpret_cast<f32x4*>(cp + t) = o4;
              }
            }
          } else {
            const u16* Zo = big;
            const u16* vto = big + (size_t)T * 1792;
            const u16* kpo = vto + (size_t)16 * 64 * 4096;
            for (int it = blockIdx.x; it < 512; it += gridDim.x) {
              int qblk = it & 7, h = (it >> 3) & 7, b = it >> 6;
              int kvh = h >> 2;
              int q0 = (qblk * 8 + wid) * 64;
              float sink2 = P.in[I_SINKS][j * 8 + h] * LOG2E;
#ifndef NO_ATTN
              attn_wave<false>(Zo + (size_t)b * 4096 * 1280 + h * 64, 1280, kpo + (size_t)(b * 2 + kvh) * 64 * 4096, 0,
                               vto + (size_t)(b * 2 + kvh) * 64 * 4096, c2, sink2, q0,
                               bufY + (size_t)b * 4096 * 1024 + h * 64, 1024);
#endif
            }
#ifndef NO_S5
            if ((nw & 31) == 0) s5_wave<false>(P, j, gw & 31, gw, nw, ldsw);
            else for (int idx = gw; idx < 16384; idx += nw) s5_wave<false>(P, j, idx & 31, idx, 16384, ldsw);
#endif
          }
          } else if constexpr (CLS == C_M2) {
          if (even) {
            const u16* Z = big;
            const u16* vt = big + (size_t)T * 1536;
            const u16* kpe = vt + (size_t)64 * 64 * 4096;
            for (int it = blockIdx.x; it < 512; it += gridDim.x) {
              int bh = it & 63, gsel = it >> 6;
              int G = gsel < 4 ? 7 - gsel : gsel - 4;
              int b = bh >> 3, h = bh & 7;
              int q0 = (G * 8 + (gsel < 4 ? wid : 7 - wid)) * 64;
#ifndef NO_ATTN
              attn_wave<true>(Z + (size_t)b * 4096 * 1536 + 1024 + h * 64, 1536, kpe + (size_t)bh * 64 * 4096, 0,
                              vt + (size_t)bh * 64 * 4096, c2 + (size_t)bh * 4096, 0.f, q0,
                              bufY + (size_t)b * 4096 * 1024 + 512 + h * 64, 1024);
#endif
            }
#ifndef NO_LRU
            for (int idx = gw; idx < 4096; idx += nw) lru_job<true>(P, j, idx >> 9, (((idx >> 3) & 63) + 32 * (idx >> 11)) & 63, idx & 7, ldsw);
#endif
          } else {
#ifndef NO_S5
            if ((nw & 31) == 0) s5_wave<true>(P, j, gw & 31, gw, nw, ldsw);
            else for (int idx = gw; idx < 16384; idx += nw) s5_wave<true>(P, j, idx & 31, idx, 16384, ldsw);
#endif
          }
          } else if constexpr (CLS == C_M3) {
          ea.aux_bf = big + (size_t)T * 1280;
          ea.aux_f0 = P.in[I_GLUB] + j * 512;
          ea.out_bf = bufY;
#ifndef NO_G_GLU
          gemm_phase<EPI_GLU>(big + (size_t)T * 1280, reinterpret_cast<const u16*>(ws + OFF_W_GLU + (size_t)j * 512 * 512 * 2), T,
                              512, 512, ea, wid);
#endif
          } else if constexpr (CLS == C_G7) {
          ea.ss_in = ss + (size_t)(4 * l + 3) * T;
          ea.ss_out = ss + (size_t)(4 * l + 4) * T;
          ea.hi_in = bufX;
          ea.lo_in = (l == 3) ? bufY : reinterpret_cast<const u16*>(P.out);
          ea.lo_out = reinterpret_cast<u16*>(P.out);
          ea.xf32_out = (l == 3) ? P.out : nullptr;
          ea.xb_out = bufY;
          ea.aux_bf = pe;
          ea.aux_f0 = sspe + (size_t)l * T;
          ea.aux_f1 = P.in[I_PLEN] + l * 1024;
#ifndef NO_G_PLEGATE
          gemm_phase<EPI_PLEGATE>(bufX, reinterpret_cast<const u16*>(ws + OFF_W_GATE + (size_t)l * 1024 * 1024 * 2), T, 1024,
                                  1024, ea, wid);
#endif
          }
}

__device__ __forceinline__ void run_kind(const Params& P, int l, int kind, const int wid) {
  switch (kind) {
    case K_G1: case K_G5: run_phase<C_SWIGLU>(P, l, kind, wid); break;
    case K_G2: case K_G4: case K_G6: run_phase<C_RESID>(P, l, kind, wid); break;
    case K_G3: run_phase<C_G3>(P, l, kind, wid); break;
    case K_M1: run_phase<C_M1>(P, l, kind, wid); break;
    case K_M2: run_phase<C_M2>(P, l, kind, wid); break;
    case K_M3: run_phase<C_M3>(P, l, kind, wid); break;
    case K_G7: run_phase<C_G7>(P, l, kind, wid); break;
    default: break;
  }
}

#ifndef PROBE_DUP
#define PROBE_DUP 0
#endif
#ifndef MULTI_LAUNCH
#define MULTI_LAUNCH 0
#endif

#if MULTI_LAUNCH
template <int CLS>
__global__ __launch_bounds__(512) void phase_k(Params P, int l, int kind) {
  const int wid = __builtin_amdgcn_readfirstlane(threadIdx.x >> 6);
  run_phase<CLS>(P, l, kind, wid);
}
#else
__global__ __launch_bounds__(512) void mega(Params P) {
  extern __shared__ __attribute__((aligned(16))) char shm_raw[];
  cg::grid_group grid = cg::this_grid();
  const int wid = __builtin_amdgcn_readfirstlane(threadIdx.x >> 6);
  unsigned* bar = reinterpret_cast<unsigned*>(P.ws + OFF_BAR);
  volatile LAS unsigned* st = (volatile LAS unsigned*)(shm_raw + 139264);
  const bool leader = threadIdx.x == 0;
  if (leader) {
    st[0] = 0u; st[1] = 0u;
    (void)xb_add(&bar[XB_XCNT(xb_xcc_id())], 1u);
  }
  run_phase<C_P0>(P, 0, 0, wid);
  grid.sync();
#if PROBE_DUP == 4
  run_phase<C_P0>(P, 0, 0, wid);
  xcd_barrier(bar, st, wid == 0 && lane_id_v() == 0);
#endif
  for (int l = 0; l < 4; ++l) {
    for (int kind = 0; kind < K_NUM; ++kind) {
      if (kind == K_M3 && (l & 1) == 0) continue;
      run_kind(P, l, kind, wid);
      xcd_barrier(bar, st, wid == 0 && lane_id_v() == 0);
#if PROBE_DUP == 1
      if (kind == K_G1 || kind == K_G5) { run_phase<C_SWIGLU>(P, l, kind, wid); xcd_barrier(bar, st, wid == 0 && lane_id_v() == 0); }
#elif PROBE_DUP == 2
      if (kind == K_M1) { run_phase<C_M1>(P, l, kind, wid); xcd_barrier(bar, st, wid == 0 && lane_id_v() == 0); }
      if (kind == K_M2) { run_phase<C_M2>(P, l, kind, wid); xcd_barrier(bar, st, wid == 0 && lane_id_v() == 0); }
#elif PROBE_DUP == 7
      if (kind == K_G2 || kind == K_G4 || kind == K_G6) { run_phase<C_RESID>(P, l, kind | 64, wid); xcd_barrier(bar, st, wid == 0 && lane_id_v() == 0); }
#elif PROBE_DUP == 9
      if (kind == K_G3) { run_phase<C_G3>(P, l, kind | 64, wid); xcd_barrier(bar, st, wid == 0 && lane_id_v() == 0); }
#elif PROBE_DUP == 5
      if (kind == K_M2 && (l & 1) == 0) { run_phase<C_M2>(P, l, kind, wid); xcd_barrier(bar, st, wid == 0 && lane_id_v() == 0); }
#elif PROBE_DUP == 6
      if (kind == K_M1 && (l & 1) == 1) { run_phase<C_M1>(P, l, kind, wid); xcd_barrier(bar, st, wid == 0 && lane_id_v() == 0); }
      if (kind == K_M2 && (l & 1) == 1) { run_phase<C_M2>(P, l, kind, wid); xcd_barrier(bar, st, wid == 0 && lane_id_v() == 0); }
#endif
    }
  }
}
#endif

extern "C" void kernel_launch(void* const* d_in, const int* in_sizes, int n_in, void* d_out, int out_size, void* d_ws,
                              size_t ws_size, hipStream_t stream) {
  if (ws_size < WS_TOTAL || n_in < N_IN) {
    fprintf(stderr, "kernel_launch: bad config ws=%zu need=%zu n_in=%d\n", ws_size, (size_t)WS_TOTAL, n_in);
    return;
  }
  Params p{};
  for (int i = 0; i < N_IN; ++i) p.in[i] = (const float*)d_in[i];
  p.out = (float*)d_out;
  p.ws = (char*)d_ws;
#if MULTI_LAUNCH
  static bool attr_done = false;
  if (!attr_done) {
    (void)hipFuncSetAttribute((const void*)phase_k<C_P0>, hipFuncAttributeMaxDynamicSharedMemorySize, LDS_BYTES);
    (void)hipFuncSetAttribute((const void*)phase_k<C_SWIGLU>, hipFuncAttributeMaxDynamicSharedMemorySize, LDS_BYTES);
    (void)hipFuncSetAttribute((const void*)phase_k<C_RESID>, hipFuncAttributeMaxDynamicSharedMemorySize, LDS_BYTES);
    (void)hipFuncSetAttribute((const void*)phase_k<C_G3>, hipFuncAttributeMaxDynamicSharedMemorySize, LDS_BYTES);
    (void)hipFuncSetAttribute((const void*)phase_k<C_M1>, hipFuncAttributeMaxDynamicSharedMemorySize, LDS_BYTES);
    (void)hipFuncSetAttribute((const void*)phase_k<C_M2>, hipFuncAttributeMaxDynamicSharedMemorySize, LDS_BYTES);
    (void)hipFuncSetAttribute((const void*)phase_k<C_M3>, hipFuncAttributeMaxDynamicSharedMemorySize, LDS_BYTES);
    (void)hipFuncSetAttribute((const void*)phase_k<C_G7>, hipFuncAttributeMaxDynamicSharedMemorySize, LDS_BYTES);
    attr_done = true;
  }
  const dim3 g(256), b(512);
  phase_k<C_P0><<<g, b, LDS_BYTES, stream>>>(p, 0, 0);
  for (int l = 0; l < 4; ++l) {
    for (int kind = 0; kind < K_NUM; ++kind) {
      if (kind == K_M3 && (l & 1) == 0) continue;
      switch (kind) {
        case K_G1: case K_G5: phase_k<C_SWIGLU><<<g, b, LDS_BYTES, stream>>>(p, l, kind); break;
        case K_G2: case K_G4: case K_G6: phase_k<C_RESID><<<g, b, LDS_BYTES, stream>>>(p, l, kind); break;
        case K_G3: phase_k<C_G3><<<g, b, LDS_BYTES, stream>>>(p, l, kind); break;
        case K_M1: phase_k<C_M1><<<g, b, LDS_BYTES, stream>>>(p, l, kind); break;
        case K_M2: phase_k<C_M2><<<g, b, LDS_BYTES, stream>>>(p, l, kind); break;
        case K_M3: phase_k<C_M3><<<g, b, LDS_BYTES, stream>>>(p, l, kind); break;
        case K_G7: phase_k<C_G7><<<g, b, LDS_BYTES, stream>>>(p, l, kind); break;
        default: break;
      }
    }
  }
#else
  static int grid_blocks = 0;
  if (!grid_blocks) {
    (void)hipFuncSetAttribute((const void*)mega, hipFuncAttributeMaxDynamicSharedMemorySize, LDS_BYTES);
    int dev = 0, cus = 0, per_cu = 0;
    (void)hipGetDevice(&dev);
    (void)hipDeviceGetAttribute(&cus, hipDeviceAttributeMultiprocessorCount, dev);
    (void)hipOccupancyMaxActiveBlocksPerMultiprocessor(&per_cu, mega, 512, LDS_BYTES);
    if (per_cu > 1) per_cu = 1;
    grid_blocks = cus * per_cu;
  }
  if (grid_blocks <= 0) { fprintf(stderr, "kernel_launch: occupancy 0\n"); return; }
  (void)hipMemsetAsync((char*)d_ws + OFF_BAR, 0, 16384, stream);
  void* args[] = {&p};
  hipError_t e = hipLaunchCooperativeKernel((const void*)mega, dim3(grid_blocks), dim3(512), args, LDS_BYTES, stream);
  if (e != hipSuccess) fprintf(stderr, "cooperative launch failed: %s (grid %d)\n", hipGetErrorString(e), grid_blocks);
#endif
}
```

```cpp
#include <hip/hip_runtime.h>
#include <hip/hip_cooperative_groups.h>
#include <cstdio>
#include <cstdint>
namespace cg = cooperative_groups;

typedef unsigned short u16;
using bf16x8 = __attribute__((ext_vector_type(8))) short;
using s16x4 = __attribute__((ext_vector_type(4))) short;
using f32x4 = __attribute__((ext_vector_type(4))) float;
using f32x16 = __attribute__((ext_vector_type(16))) float;

constexpr int T = 32768, SEQ = 4096;
constexpr float EPS = 1e-6f;
constexpr float LOG2E = 1.4426950408889634f;
constexpr float QSCALE = 0.125f * LOG2E;

enum { I_X, I_P, I_F1N, I_F1G, I_F1U, I_F1D, I_MIXN, I_F2N, I_F2G, I_F2U, I_F2D, I_PLEW, I_PLEN, I_PLEGN, I_PLEGW,
       I_EVIN, I_CONVW, I_CONVB, I_WA, I_BA, I_WX, I_BX, I_LAM, I_FOXBF, I_FOXQN, I_FOXKN, I_EVOUT,
       I_ODIN, I_SWAQN, I_SWAKN, I_SINKS, I_S5LRE, I_S5LIM, I_S5LOGDT, I_S5BRE, I_S5BIM, I_S5CRE, I_S5CIM, I_S5D,
       I_GLUW, I_GLUB, I_ODOUT, N_IN };

struct Params {
  const float* in[N_IN];
  float* out;
  char* ws;
};

constexpr size_t SZ_FFNGU = (size_t)5632 * 1024 * 2, SZ_FFND = (size_t)1024 * 2816 * 2;
constexpr size_t OFF_W_F1GU = 0;
constexpr size_t OFF_W_F1D = OFF_W_F1GU + 4 * SZ_FFNGU;
constexpr size_t OFF_W_F2GU = OFF_W_F1D + 4 * SZ_FFND;
constexpr size_t OFF_W_F2D = OFF_W_F2GU + 4 * SZ_FFNGU;
constexpr size_t OFF_W_PLE = OFF_W_F2D + 4 * SZ_FFND;
constexpr size_t OFF_W_GATE = OFF_W_PLE + 4 * (size_t)1024 * 256 * 2;
constexpr size_t OFF_W_EVIN = OFF_W_GATE + 4 * (size_t)1024 * 1024 * 2;
constexpr size_t OFF_W_EVOUT = OFF_W_EVIN + 2 * (size_t)2816 * 1024 * 2;
constexpr size_t OFF_W_ODIN = OFF_W_EVOUT + 2 * (size_t)1024 * 1024 * 2;
constexpr size_t OFF_W_ODOUT = OFF_W_ODIN + 2 * (size_t)1280 * 1024 * 2;
constexpr size_t OFF_W_GLU = OFF_W_ODOUT + 2 * (size_t)1024 * 1024 * 2;
constexpr size_t OFF_W_ODV = OFF_W_GLU + 2 * (size_t)512 * 512 * 2;
constexpr size_t OFF_W_LRU = OFF_W_ODV + 2 * (size_t)256 * 1024 * 2;
constexpr size_t OFF_BUFX = OFF_W_LRU + (size_t)2 * 2 * 8 * 64 * 64 * 2;
constexpr size_t OFF_BUFY = OFF_BUFX + (size_t)T * 1024 * 2;
constexpr size_t OFF_PE = OFF_BUFY + (size_t)T * 1024 * 2;
constexpr size_t OFF_PBF = OFF_PE + (size_t)T * 1024 * 2;
constexpr size_t OFF_BIG = OFF_PBF + (size_t)T * 256 * 2;
constexpr size_t SZ_BIG = (size_t)T * 2816 * 2;
constexpr size_t OFF_SS = OFF_BIG + SZ_BIG;
constexpr size_t OFF_SSPE = OFF_SS + (size_t)17 * T * 4;
constexpr size_t OFF_FLOG = OFF_SSPE + (size_t)4 * T * 4;
constexpr size_t OFF_C2 = OFF_FLOG + (size_t)T * 8 * 4;
constexpr size_t OFF_LRUAGG = OFF_C2 + (size_t)64 * 4096 * 4;
constexpr size_t OFF_S5END = OFF_LRUAGG + (size_t)8 * 64 * 512 * 2 * 4;
constexpr size_t OFF_ROPE = OFF_S5END + (size_t)8 * 64 * 32 * 64 * 8;
constexpr size_t OFF_BAR = OFF_ROPE + (size_t)4096 * 32 * 8;
constexpr size_t WS_TOTAL = OFF_BAR + 16384;

constexpr int LDS_BYTES = 139264 + 16;
constexpr int LDS_WAVE = 17408;

__device__ __forceinline__ int lane_id_v() {
  int l;
  asm volatile("v_mbcnt_lo_u32_b32 %0, -1, 0\n\tv_mbcnt_hi_u32_b32 %0, -1, %0" : "=v"(l));
  return l;
}
__device__ __forceinline__ u16 f2bf(float f) {
  uint32_t u = __float_as_uint(f);
  u += 0x7fffu + ((u >> 16) & 1u);
  return (u16)(u >> 16);
}
__device__ __forceinline__ float bf2f(u16 h) { return __uint_as_float(((uint32_t)h) << 16); }
__device__ __forceinline__ uint32_t pack2(float a, float b) {
  uint32_t r;
  asm("v_cvt_pk_bf16_f32 %0, %1, %2" : "=v"(r) : "v"(a), "v"(b));
  return r;
}
__device__ __forceinline__ float sigmoidf_(float x) { return __builtin_amdgcn_rcpf(1.f + __expf(-x)); }
__device__ __forceinline__ float gelu_tanh(float x) {
  float u = 0.7978845608028654f * (x + 0.044715f * x * x * x);
  float e = __expf(2.f * u);
  float th = 1.f - 2.f * __builtin_amdgcn_rcpf(1.f + e);
  return 0.5f * x * (1.f + th);
}
__device__ __forceinline__ float ex2(float x) { return __builtin_amdgcn_exp2f(x); }
typedef unsigned u32x2_t __attribute__((ext_vector_type(2)));
__device__ __forceinline__ float xsum32(float x) {
  u32x2_t r = __builtin_amdgcn_permlane32_swap(__float_as_uint(x), __float_as_uint(x), false, false);
  return __uint_as_float(r.x) + __uint_as_float(r.y);
}
__device__ __forceinline__ float xmax32(float x) {
  u32x2_t r = __builtin_amdgcn_permlane32_swap(__float_as_uint(x), __float_as_uint(x), false, false);
  return fmaxf(__uint_as_float(r.x), __uint_as_float(r.y));
}
__device__ __forceinline__ float xsum16(float x) {
  u32x2_t r = __builtin_amdgcn_permlane16_swap(__float_as_uint(x), __float_as_uint(x), false, false);
  return __uint_as_float(r.x) + __uint_as_float(r.y);
}


struct TDesc {
  const float* src0;
  const float* src1;
  const float* gain;
  u16* dst;
  int ldsrc, Nlog, K, mode, coloff, tile;
};

__device__ __forceinline__ void transpose_tile(const TDesc& d, float* tile, int tid) {
  const int tiles_k = d.K / 64;
  const int tr = d.tile / tiles_k, tk = d.tile % tiles_k;
  const int r0 = tr * 256, k0 = tk * 64;
  {
    const int rq = (tid & 63) * 4, kq = tid >> 6;
    const int r = r0 + rq;
    const int c = r & 255;
    const float* sp = d.src0;
    int scol;
    bool valid = true;
    if (d.mode == 0) {
      scol = d.coloff + (r >> 8) * 256 + ((c & 127) >> 5) * 64 + (c >> 7) * 32 + (c & 31);
      valid = scol < d.Nlog;
    } else if (d.mode == 3) {
      const int p = c & 31;
      scol = d.coloff + (r >> 8) * 256 + ((c & 127) >> 5) * 64 + (c >> 7) * 32 + 8 * ((p >> 2) & 3) + 4 * (p >> 4) + (p & 3);
      valid = scol < d.Nlog;
    } else if (d.mode == 2) {
      scol = d.coloff + r;
      valid = scol < d.Nlog;
    } else {
      const int p = c & 31;
      scol = (r >> 8) * 128 + ((c & 127) >> 5) * 32 + 8 * ((p >> 2) & 3) + 4 * (p >> 4) + (p & 3);
      sp = (c >> 7) ? d.src1 : d.src0;
    }
    f32x4 v[8];
#pragma unroll
    for (int i = 0; i < 8; ++i) {
      const int k = k0 + kq + 8 * i;
      v[i] = valid ? *reinterpret_cast<const f32x4*>(sp + (size_t)k * d.ldsrc + scol) : (f32x4){0.f, 0.f, 0.f, 0.f};
    }
#pragma unroll
    for (int i = 0; i < 8; ++i) {
      const int kl = kq + 8 * i;
      const float g = d.gain ? d.gain[k0 + kl] : 1.f;
      float* tp = tile + kl * 257 + rq;
      tp[0] = v[i][0] * g; tp[1] = v[i][1] * g; tp[2] = v[i][2] * g; tp[3] = v[i][3] * g;
    }
  }
  __syncthreads();
  {
    const int rl = tid >> 1, kseg = (tid & 1) * 32;
    u16* dp = d.dst + (size_t)(r0 + rl) * d.K + k0 + kseg;
#pragma unroll
    for (int q = 0; q < 4; ++q) {
      const float* tp = tile + (kseg + q * 8) * 257 + rl;
      uint4 pk;
      pk.x = pack2(tp[0 * 257], tp[1 * 257]);
      pk.y = pack2(tp[2 * 257], tp[3 * 257]);
      pk.z = pack2(tp[4 * 257], tp[5 * 257]);
      pk.w = pack2(tp[6 * 257], tp[7 * 257]);
      *reinterpret_cast<uint4*>(dp + q * 8) = pk;
    }
  }
  __syncthreads();
}

constexpr int TL_LAYER = 1136, TL_MIX = 416, TL_TOTAL = 4 * TL_LAYER + 2 * TL_MIX;
__device__ __forceinline__ TDesc weight_tile_desc(const Params& P, int g) {
  TDesc d{};
  char* ws = P.ws;
  if (g < 4 * TL_LAYER) {
    const int l = g / TL_LAYER, r = g % TL_LAYER;
    if (r < 704) {
      const bool second = r >= 352;
      d.tile = second ? r - 352 : r;
      d.src0 = P.in[second ? I_F2G : I_F1G] + (size_t)l * 1024 * 2816;
      d.src1 = P.in[second ? I_F2U : I_F1U] + (size_t)l * 1024 * 2816;
      d.gain = P.in[second ? I_F2N : I_F1N] + l * 1024;
      d.dst = reinterpret_cast<u16*>(ws + (second ? OFF_W_F2GU : OFF_W_F1GU) + l * SZ_FFNGU);
      d.ldsrc = 2816; d.Nlog = 0; d.K = 1024; d.mode = 1; d.coloff = 0;
    } else if (r < 1056) {
      const bool second = r >= 880;
      d.tile = second ? r - 880 : r - 704;
      d.src0 = P.in[second ? I_F2D : I_F1D] + (size_t)l * 2816 * 1024;
      d.dst = reinterpret_cast<u16*>(ws + (second ? OFF_W_F2D : OFF_W_F1D) + l * SZ_FFND);
      d.ldsrc = 1024; d.Nlog = 1024; d.K = 2816; d.mode = 3;
    } else if (r < 1072) {
      d.tile = r - 1056;
      d.src0 = P.in[I_PLEW] + (size_t)l * 256 * 1024;
      d.dst = reinterpret_cast<u16*>(ws + OFF_W_PLE + (size_t)l * 1024 * 256 * 2);
      d.ldsrc = 1024; d.Nlog = 1024; d.K = 256; d.mode = 3;
    } else {
      d.tile = r - 1072;
      d.src0 = P.in[I_PLEGW] + (size_t)l * 1024 * 1024;
      d.gain = P.in[I_PLEGN] + l * 1024;
      d.dst = reinterpret_cast<u16*>(ws + OFF_W_GATE + (size_t)l * 1024 * 1024 * 2);
      d.ldsrc = 1024; d.Nlog = 1024; d.K = 1024; d.mode = 3;
    }
  } else {
    const int g2 = g - 4 * TL_LAYER;
    const int j = g2 / TL_MIX, r = g2 % TL_MIX;
    if (r < 176) {
      d.src0 = P.in[I_EVIN] + (size_t)j * 1024 * 2568;
      d.gain = P.in[I_MIXN] + (2 * j) * 1024;
      u16* dst = reinterpret_cast<u16*>(ws + OFF_W_EVIN + (size_t)j * 2816 * 1024 * 2);
      d.ldsrc = 2568; d.K = 1024;
      if (r < 128) { d.tile = r; d.dst = dst; d.Nlog = 2048; d.mode = 0; d.coloff = 0; }
      else if (r < 144) { d.tile = r - 128; d.dst = dst + (size_t)2048 * 1024; d.Nlog = 2568; d.mode = 0; d.coloff = 2560; }
      else { d.tile = r - 144; d.dst = dst + (size_t)2304 * 1024; d.Nlog = 2560; d.mode = 2; d.coloff = 2048; }
    } else if (r < 240) {
      d.tile = r - 176;
      d.src0 = P.in[I_EVOUT] + (size_t)j * 1024 * 1024;
      d.dst = reinterpret_cast<u16*>(ws + OFF_W_EVOUT + (size_t)j * 1024 * 1024 * 2);
      d.ldsrc = 1024; d.Nlog = 1024; d.K = 1024; d.mode = 3;
    } else if (r < 336) {
      d.src0 = P.in[I_ODIN] + (size_t)j * 1024 * 1280;
      d.gain = P.in[I_MIXN] + (2 * j + 1) * 1024;
      d.ldsrc = 1280; d.K = 1024;
      if (r < 320) { d.tile = r - 240; d.dst = reinterpret_cast<u16*>(ws + OFF_W_ODIN + (size_t)j * 1280 * 1024 * 2); d.Nlog = 1280; d.mode = 0; d.coloff = 0; }
      else { d.tile = r - 320; d.dst = reinterpret_cast<u16*>(ws + OFF_W_ODV + (size_t)j * 256 * 1024 * 2); d.Nlog = 768; d.mode = 2; d.coloff = 640; }
    } else if (r < 400) {
      d.tile = r - 336;
      d.src0 = P.in[I_ODOUT] + (size_t)j * 1024 * 1024;
      d.dst = reinterpret_cast<u16*>(ws + OFF_W_ODOUT + (size_t)j * 1024 * 1024 * 2);
      d.ldsrc = 1024; d.Nlog = 1024; d.K = 1024; d.mode = 3;
    } else {
      d.tile = r - 400;
      d.src0 = P.in[I_GLUW] + (size_t)j * 512 * 512;
      d.dst = reinterpret_cast<u16*>(ws + OFF_W_GLU + (size_t)j * 512 * 512 * 2);
      d.ldsrc = 512; d.Nlog = 512; d.K = 512; d.mode = 0;
    }
  }
  return d;
}

#define LAS __attribute__((address_space(3)))
constexpr int BM = 256, BK = 64, HALF = 128, HTB = HALF * BK * 2;

__device__ __forceinline__ int lds_byte(int r, int c) {
  const int st = (r >> 4) * 2 + (c >> 5), rr = r & 15, cc = c & 31, ob = rr * 64 + cc * 2;
  return st * 1024 + (ob ^ (((ob >> 9) & 1) << 5));
}
__device__ __forceinline__ void stage_rc(int b, int& R, int& C) {
  const int st = b / 1024, sb = b % 1024, swz = sb ^ (((sb >> 9) & 1) << 5);
  R = (st >> 1) * 16 + swz / 64;
  C = (st & 1) * 32 + (swz % 64) / 2;
}

struct Unit { int pm, pn; };
struct Order {
  int nM, nN, nwg, spx, qx, xcd, off;
  bool remap, pesplit;
  __device__ __forceinline__ void init(int M, int N, int offshift) {
    nM = M / BM; nN = N / BM; nwg = nM * nN;
    remap = ((gridDim.x & 7) == 0) && ((nwg & 7) == 0);
    spx = gridDim.x >> 3; qx = nwg >> 3; xcd = blockIdx.x & 7; off = blockIdx.x >> 3;
    pesplit = (offshift < 0) && remap && spx == 32 && qx == 64;
    if (remap && offshift > 0) off = (off + offshift) % spx;
  }
  __device__ __forceinline__ bool next(int it, Unit& u) const {
    int wg;
    if (pesplit) {
      int li;
      if (off >= 16) { if (it >= 3) return false; li = (off - 16) + 16 * it; }
      else { if (it >= 1) return false; li = 48 + off; }
      wg = xcd * qx + li;
    } else if (remap) {
      int li = it * spx + off;
      if (li >= qx) return false;
      wg = xcd * qx + li;
    } else {
      wg = it * (int)gridDim.x + (int)blockIdx.x;
      if (wg >= nwg) return false;
    }
    const int nig = 8 * nN, gid = wg / nig, fm = gid * 8, gsz = (nM - fm) < 8 ? (nM - fm) : 8;
    u.pm = fm + ((wg % nig) % gsz);
    u.pn = (wg % nig) / gsz;
    return true;
  }
};

enum { EPI_SWIGLU, EPI_RESID, EPI_EVEN, EPI_ODD, EPI_PE, EPI_PLEGATE, EPI_GLU, EPI_VT };

struct EpiArgs {
  const float* ss_in;
  float* ss_out;
  const u16* hi_in;
  const u16* lo_in;
  u16* lo_out;
  float* xf32_out;
  u16* xb_out;
  u16* out_bf;
  const u16* aux_bf;
  const float* aux_f0;
  const float* aux_f1;
  const float* aux_f2;
  u16* vt;
  u16* kp;
  float* flog;
  float alpha;
  int nh;
};

__device__ __forceinline__ float rstd_of(float ssv) { return rsqrtf(ssv * (1.f / 1024.f) + EPS); }
__device__ __forceinline__ uint2 pack4(f32x4 v) {
  uint2 r;
  r.x = pack2(v[0], v[1]);
  r.y = pack2(v[2], v[3]);
  return r;
}

template <int EPI>
__device__ __forceinline__ void gemm_epilogue(const f32x4 (&acc)[2][2][4][2], const Unit& u, int wr, int wc, int fr, int fq,
                                              const EpiArgs& ea, const float (&rs_pre)[2][4]) {
  const int row0 = u.pm * 256 + wr * 64 + fr;
  const int lc0 = u.pn * 256 + wc * 64 + 4 * fq;
  float rsr[2][4];
  if constexpr (EPI == EPI_SWIGLU || EPI == EPI_PLEGATE || EPI == EPI_EVEN || EPI == EPI_ODD) {
#pragma unroll
    for (int ai = 0; ai < 2; ++ai)
#pragma unroll
      for (int m = 0; m < 4; ++m)
        rsr[ai][m] = (EPI == EPI_SWIGLU || EPI == EPI_PLEGATE) ? rs_pre[ai][m] : ea.ss_in[row0 + ai * 128 + m * 16];
#pragma unroll
    for (int ai = 0; ai < 2; ++ai)
#pragma unroll
      for (int m = 0; m < 4; ++m) rsr[ai][m] = rstd_of(rsr[ai][m]);
  }
  if constexpr (EPI == EPI_SWIGLU) {
#pragma unroll
    for (int ai = 0; ai < 2; ++ai)
#pragma unroll
      for (int m = 0; m < 4; ++m) {
        const int row = row0 + ai * 128 + m * 16;
        const float rs = rsr[ai][m];
        u16* rowp = ea.out_bf + (size_t)row * 2816 + u.pn * 128 + wc * 32 + 8 * fq;
        uint2 hp2[2];
#pragma unroll
        for (int n = 0; n < 2; ++n) {
          f32x4 g = acc[ai][0][m][n] * rs, uu = acc[ai][1][m][n] * rs, h;
#pragma unroll
          for (int i = 0; i < 4; ++i) h[i] = g[i] * sigmoidf_(g[i]) * uu[i];
          hp2[n] = pack4(h);
        }
        *reinterpret_cast<uint4*>(rowp) = make_uint4(hp2[0].x, hp2[0].y, hp2[1].x, hp2[1].y);
      }
  } else if constexpr (EPI == EPI_RESID || EPI == EPI_PLEGATE) {
    float rper[2][4];
    if constexpr (EPI == EPI_PLEGATE) {
#pragma unroll
      for (int ai = 0; ai < 2; ++ai)
#pragma unroll
        for (int m = 0; m < 4; ++m) rper[ai][m] = ea.aux_f0[row0 + ai * 128 + m * 16];
#pragma unroll
      for (int ai = 0; ai < 2; ++ai)
#pragma unroll
        for (int m = 0; m < 4; ++m) rper[ai][m] = rstd_of(rper[ai][m]);
    }
    const int lcp = u.pn * 256 + wc * 64 + 8 * fq;
    uint4 hc[2], hn[2], lc[2], ln_[2], pc[2], pq[2];
#define EPI_LOAD_ROW(IT, HH, LL, PP)                                                                  \
  {                                                                                                   \
    const size_t rb_ = (size_t)(row0 + ((IT) >> 2) * 128 + ((IT)&3) * 16) * 1024 + lcp;               \
    _Pragma("unroll") for (int bj = 0; bj < 2; ++bj) {                                                \
      HH[bj] = *reinterpret_cast<const uint4*>(ea.hi_in + rb_ + bj * 32);                             \
      LL[bj] = *reinterpret_cast<const uint4*>(ea.lo_in + rb_ + bj * 32);                             \
      if constexpr (EPI == EPI_PLEGATE) PP[bj] = *reinterpret_cast<const uint4*>(ea.aux_bf + rb_ + bj * 32); \
    }                                                                                                 \
  }
    EPI_LOAD_ROW(0, hc, lc, pc);
#pragma unroll
    for (int it = 0; it < 8; ++it) {
      const int ai = it >> 2, m = it & 3;
      if (it + 1 < 8) EPI_LOAD_ROW(it + 1, hn, ln_, pq);
      const int row = row0 + ai * 128 + m * 16;
      float sq = 0.f;
#pragma unroll
      for (int bj = 0; bj < 2; ++bj) {
        const size_t idx = (size_t)row * 1024 + lcp + bj * 32;
        const uint32_t hw[4] = {hc[bj].x, hc[bj].y, hc[bj].z, hc[bj].w};
        const uint32_t lw[4] = {lc[bj].x, lc[bj].y, lc[bj].z, lc[bj].w};
        const uint32_t pw[4] = {pc[bj].x, pc[bj].y, pc[bj].z, pc[bj].w};
        uint32_t ho[4], lo_[4];
#pragma unroll
        for (int n = 0; n < 2; ++n) {
          f32x4 xv;
          xv[0] = __uint_as_float(hw[2 * n] << 16) + __uint_as_float(lw[2 * n] << 16);
          xv[1] = __uint_as_float(hw[2 * n] & 0xffff0000u) + __uint_as_float(lw[2 * n] & 0xffff0000u);
          xv[2] = __uint_as_float(hw[2 * n + 1] << 16) + __uint_as_float(lw[2 * n + 1] << 16);
          xv[3] = __uint_as_float(hw[2 * n + 1] & 0xffff0000u) + __uint_as_float(lw[2 * n + 1] & 0xffff0000u);
          const f32x4 a = acc[ai][bj][m][n];
          f32x4 v;
          if constexpr (EPI == EPI_PLEGATE) {
            const float rs = rsr[ai][m], rpe = rper[ai][m];
            const float pv[4] = {__uint_as_float(pw[2 * n] << 16), __uint_as_float(pw[2 * n] & 0xffff0000u),
                                 __uint_as_float(pw[2 * n + 1] << 16), __uint_as_float(pw[2 * n + 1] & 0xffff0000u)};
#pragma unroll
            for (int i = 0; i < 4; ++i) v[i] = xv[i] + sigmoidf_(a[i] * rs) * (pv[i] * rpe);
          } else {
            v = xv + a * ea.alpha;
          }
          const uint2 hnew = pack4(v);
          ho[2 * n] = hnew.x; ho[2 * n + 1] = hnew.y;
          if (ea.xf32_out) {
            *reinterpret_cast<f32x4*>(ea.xf32_out + idx + 4 * n) = v;
          } else {
            f32x4 r;
            r[0] = v[0] - __uint_as_float(hnew.x << 16);
            r[1] = v[1] - __uint_as_float(hnew.x & 0xffff0000u);
            r[2] = v[2] - __uint_as_float(hnew.y << 16);
            r[3] = v[3] - __uint_as_float(hnew.y & 0xffff0000u);
            const uint2 lnew = pack4(r);
            lo_[2 * n] = lnew.x; lo_[2 * n + 1] = lnew.y;
          }
          sq += v[0] * v[0] + v[1] * v[1] + v[2] * v[2] + v[3] * v[3];
        }
        if (!ea.xf32_out) {
          *reinterpret_cast<uint4*>(ea.xb_out + idx) = make_uint4(ho[0], ho[1], ho[2], ho[3]);
          *reinterpret_cast<uint4*>(ea.lo_out + idx) = make_uint4(lo_[0], lo_[1], lo_[2], lo_[3]);
        }
      }
      sq = xsum32(xsum16(sq));
      if (fq == 0) atomicAdd(&ea.ss_out[row], sq);
      if (it + 1 < 8) {
#pragma unroll
        for (int bj = 0; bj < 2; ++bj) { hc[bj] = hn[bj]; lc[bj] = ln_[bj]; pc[bj] = pq[bj]; }
      }
    }
#undef EPI_LOAD_ROW
  } else if constexpr (EPI == EPI_PE) {
    const int lcp = u.pn * 256 + wc * 64 + 8 * fq;
    f32x4 gnv[2][2];
#pragma unroll
    for (int bj = 0; bj < 2; ++bj)
#pragma unroll
      for (int n = 0; n < 2; ++n) gnv[bj][n] = *reinterpret_cast<const f32x4*>(ea.aux_f1 + lcp + bj * 32 + 4 * n);
#pragma unroll
    for (int ai = 0; ai < 2; ++ai)
#pragma unroll
      for (int m = 0; m < 4; ++m) {
        const int row = row0 + ai * 128 + m * 16;
        float sq = 0.f;
#pragma unroll
        for (int bj = 0; bj < 2; ++bj) {
          uint2 pk2[2];
#pragma unroll
          for (int n = 0; n < 2; ++n) {
            f32x4 a = acc[ai][bj][m][n];
            pk2[n] = pack4(a * gnv[bj][n]);
            sq += a[0] * a[0] + a[1] * a[1] + a[2] * a[2] + a[3] * a[3];
          }
          *reinterpret_cast<uint4*>(ea.out_bf + (size_t)row * 1024 + lcp + bj * 32) = make_uint4(pk2[0].x, pk2[0].y, pk2[1].x, pk2[1].y);
        }
        sq = xsum32(xsum16(sq));
        if (fq == 0) atomicAdd(&ea.ss_out[row], sq);
      }
  } else if constexpr (EPI == EPI_GLU) {
    f32x4 gbv[2][2];
#pragma unroll
    for (int bj = 0; bj < 2; ++bj)
#pragma unroll
      for (int n = 0; n < 2; ++n) gbv[bj][n] = *reinterpret_cast<const f32x4*>(ea.aux_f0 + lc0 + bj * 32 + n * 16);
    uint2 zc[2][2], zn[2][2];
#pragma unroll
    for (int bj = 0; bj < 2; ++bj)
#pragma unroll
      for (int n = 0; n < 2; ++n) zc[bj][n] = *reinterpret_cast<const uint2*>(ea.aux_bf + (size_t)row0 * 512 + lc0 + bj * 32 + n * 16);
#pragma unroll
    for (int it = 0; it < 8; ++it) {
      const int ai = it >> 2, m = it & 3;
      const int row = row0 + ai * 128 + m * 16;
      if (it + 1 < 8) {
        const int rown = row0 + ((it + 1) >> 2) * 128 + ((it + 1) & 3) * 16;
#pragma unroll
        for (int bj = 0; bj < 2; ++bj)
#pragma unroll
          for (int n = 0; n < 2; ++n) zn[bj][n] = *reinterpret_cast<const uint2*>(ea.aux_bf + (size_t)rown * 512 + lc0 + bj * 32 + n * 16);
      }
#pragma unroll
      for (int bj = 0; bj < 2; ++bj)
#pragma unroll
        for (int n = 0; n < 2; ++n) {
          const int col = lc0 + bj * 32 + n * 16;
          const uint2 zw = zc[bj][n];
          const float zv[4] = {__uint_as_float(zw.x << 16), __uint_as_float(zw.x & 0xffff0000u), __uint_as_float(zw.y << 16),
                               __uint_as_float(zw.y & 0xffff0000u)};
          f32x4 a = acc[ai][bj][m][n], o;
#pragma unroll
          for (int i = 0; i < 4; ++i) o[i] = zv[i] * sigmoidf_(a[i] + gbv[bj][n][i]);
          *reinterpret_cast<uint2*>(ea.out_bf + (size_t)row * 1024 + 512 + col) = pack4(o);
        }
      if (it + 1 < 8) {
#pragma unroll
        for (int bj = 0; bj < 2; ++bj)
#pragma unroll
          for (int n = 0; n < 2; ++n) zc[bj][n] = zn[bj][n];
      }
    }
  } else if constexpr (EPI == EPI_EVEN || EPI == EPI_ODD) {
    const int unit = u.pn * 4 + wc;
    constexpr int LD = (EPI == EPI_EVEN) ? 1536 : 1280;
    const int qlo = (EPI == EPI_EVEN) ? 16 : 0, qhi = (EPI == EPI_EVEN) ? 24 : 8, khi = (EPI == EPI_EVEN) ? 32 : 10;
    const bool plain = (EPI == EPI_EVEN) ? (unit < 16) : (unit >= 12);
    if (plain) {
#pragma unroll
      for (int ai = 0; ai < 2; ++ai)
#pragma unroll
        for (int m = 0; m < 4; ++m) {
          const int row = row0 + ai * 128 + m * 16;
          const float rs = rsr[ai][m];
#pragma unroll
          for (int bj = 0; bj < 2; ++bj)
#pragma unroll
            for (int n = 0; n < 2; ++n)
              *reinterpret_cast<uint2*>(ea.out_bf + (size_t)row * LD + lc0 + bj * 32 + n * 16) = pack4(acc[ai][bj][m][n] * rs);
        }
    } else if (unit >= qlo && unit < khi) {
      const bool isq = unit < qhi;
      const float* gn = isq ? ea.aux_f0 : ea.aux_f1;
      const float sc = isq ? QSCALE : 1.f;
      f32x4 gv[2][2];
#pragma unroll
      for (int bj = 0; bj < 2; ++bj)
#pragma unroll
        for (int n = 0; n < 2; ++n) gv[bj][n] = *reinterpret_cast<const f32x4*>(gn + bj * 32 + n * 16 + 4 * fq) * sc;
#pragma unroll
      for (int ai = 0; ai < 2; ++ai)
#pragma unroll
        for (int m = 0; m < 4; ++m) {
          const int row = row0 + ai * 128 + m * 16;
          const float rs = rsr[ai][m];
          f32x4 v[2][2];
          float sq = 0.f;
#pragma unroll
          for (int bj = 0; bj < 2; ++bj)
#pragma unroll
            for (int n = 0; n < 2; ++n) {
              v[bj][n] = acc[ai][bj][m][n] * rs;
              sq += v[bj][n][0] * v[bj][n][0] + v[bj][n][1] * v[bj][n][1] + v[bj][n][2] * v[bj][n][2] + v[bj][n][3] * v[bj][n][3];
            }
          sq = xsum32(xsum16(sq));
          const float hr = rsqrtf(sq * (1.f / 64.f) + EPS);
#pragma unroll
          for (int bj = 0; bj < 2; ++bj)
#pragma unroll
            for (int n = 0; n < 2; ++n) v[bj][n] = v[bj][n] * hr * gv[bj][n];
          if constexpr (EPI == EPI_ODD) {
            const int pos = row & 4095;
            const float2* rope = reinterpret_cast<const float2*>(ea.aux_f2) + pos * 32 + 4 * fq;
#pragma unroll
            for (int n = 0; n < 2; ++n) {
              f32x4 c01 = *reinterpret_cast<const f32x4*>(rope + n * 16);
              f32x4 c23 = *reinterpret_cast<const f32x4*>(rope + n * 16 + 2);
              float cs[4] = {c01[0], c01[2], c23[0], c23[2]}, sn[4] = {c01[1], c01[3], c23[1], c23[3]};
              f32x4 x1 = v[0][n], x2 = v[1][n];
#pragma unroll
              for (int i = 0; i < 4; ++i) {
                v[0][n][i] = x1[i] * cs[i] - x2[i] * sn[i];
                v[1][n][i] = x2[i] * cs[i] + x1[i] * sn[i];
              }
            }
          }
          if (isq) {
#pragma unroll
            for (int bj = 0; bj < 2; ++bj)
#pragma unroll
              for (int n = 0; n < 2; ++n)
                *reinterpret_cast<uint2*>(ea.out_bf + (size_t)row * LD + lc0 + bj * 32 + n * 16) = pack4(v[bj][n]);
          } else {
            const int kh = unit - qhi, b = row >> 12, t = row & 4095;
            u16* kb = ea.kp + ((size_t)((b * ea.nh + kh) * 128 + (t >> 5)) * 4) * 512 + ((fq >> 1) * 32 + (t & 31)) * 8 + (fq & 1) * 4;
#pragma unroll
            for (int bj = 0; bj < 2; ++bj)
#pragma unroll
              for (int n = 0; n < 2; ++n) *reinterpret_cast<uint2*>(kb + (bj * 2 + n) * 512) = pack4(v[bj][n]);
          }
        }
    } else if (EPI == EPI_EVEN && unit == 32) {
      if (fq < 2) {
        f32x4 bfv = *reinterpret_cast<const f32x4*>(ea.aux_f2 + 4 * fq);
#pragma unroll
        for (int ai = 0; ai < 2; ++ai)
#pragma unroll
          for (int m = 0; m < 4; ++m) {
            const int row = row0 + ai * 128 + m * 16;
            const float rs = rsr[ai][m];
            f32x4 o;
#pragma unroll
            for (int i = 0; i < 4; ++i) {
              float xv = acc[ai][0][m][0][i] * rs + bfv[i];
              o[i] = fminf(xv, 0.f) - log1pf(__expf(-fabsf(xv)));
            }
            *reinterpret_cast<f32x4*>(ea.flog + (size_t)row * 8 + 4 * fq) = o;
          }
      }
    }
  } else if constexpr (EPI == EPI_VT) {
    f32x4 rsv[2][2];
#pragma unroll
    for (int bj = 0; bj < 2; ++bj)
#pragma unroll
      for (int n = 0; n < 2; ++n) rsv[bj][n] = *reinterpret_cast<const f32x4*>(ea.ss_in + u.pn * 256 + bj * 128 + wc * 32 + n * 16 + 4 * fq);
#pragma unroll
    for (int bj = 0; bj < 2; ++bj)
#pragma unroll
      for (int n = 0; n < 2; ++n) {
        const int tok = u.pn * 256 + bj * 128 + wc * 32 + n * 16 + 4 * fq;
        f32x4 rs;
#pragma unroll
        for (int i = 0; i < 4; ++i) rs[i] = rstd_of(rsv[bj][n][i]);
        const int b = tok >> 12, t = tok & 4095;
        const int tt = t & 31, uu = tt & 15;
        const int sub = (tt >> 4) * 512 + (((uu & 7) >> 2) * 32) * 8 + (uu >> 3) * 4;
#pragma unroll
        for (int ai = 0; ai < 2; ++ai) {
          const int hv = u.pm * 4 + ai * 2 + wr;
          if (hv < ea.nh) {
            u16* vb = ea.vt + ((size_t)((b * ea.nh + hv) * 128 + (t >> 5)) * 4) * 512 + sub;
#pragma unroll
            for (int m = 0; m < 4; ++m) {
              const int d = m * 16 + fr;
              *reinterpret_cast<uint2*>(vb + (d >> 5) * 1024 + (d & 31) * 8) = pack4(acc[ai][bj][m][n] * rs);
            }
          }
        }
      }
  }
}

template <int EPI>
__device__ __forceinline__ void gemm_phase(const u16* __restrict__ Ag, const u16* __restrict__ Btg, int M, int N, int K,
                                           const EpiArgs& ea, const int wid, const int offshift = 0) {
  asm volatile("" : "+s"(K));
  extern __shared__ __attribute__((aligned(16))) char shm_raw[];
  LAS unsigned char* lds = (LAS unsigned char*)shm_raw;
  const int lane = lane_id_v(), tid = wid * 64 + lane, wr = wid >> 2, wc = wid & 3, fr = lane & 15, fq = lane >> 4;
  const int nt = K / BK;
  unsigned voff[2];
#pragma unroll
  for (int i = 0; i < 2; ++i) {
    int R, C;
    stage_rc(tid * 16 + i * 8192, R, C);
    voff[i] = (unsigned)(R * K + C) * 2u;
  }
  const size_t kstep = (size_t)(BK * 2);
  const size_t hstep = (size_t)HALF * K * 2;
  const size_t tstep = 2 * hstep;
  const unsigned ldsw = (unsigned)wid * 1024u;
  const int aoff = lds_byte(wr * 64 + fr, fq * 8), boff = lds_byte(wc * 32 + fr, fq * 8);
#define G_SA(b, h) (((b)*2 + (h)) * HTB)
#define G_SB(b, h) ((4 + (b)*2 + (h)) * HTB)
#define G_STAGE(bufoff, gbase)                                                                                          \
  do {                                                                                                                  \
    _Pragma("unroll") for (int _i = 0; _i < 2; ++_i) __builtin_amdgcn_global_load_lds(                                  \
        (const unsigned*)((const char*)(gbase) + voff[_i]), (LAS unsigned*)(lds + (bufoff) + ldsw + _i * 8192), 16, 0, 0); \
  } while (0)
#define G_LDA(dst, b, h)                                                                                                \
  do {                                                                                                                  \
    _Pragma("unroll") for (int m = 0; m < 4; ++m) _Pragma("unroll") for (int k = 0; k < 2; ++k) dst[m][k] =             \
        *(const LAS bf16x8*)(lds + G_SA(b, h) + aoff + m * 2048 + k * 1024);                                            \
  } while (0)
#define G_LDB(dst, b, h)                                                                                                \
  do {                                                                                                                  \
    _Pragma("unroll") for (int n = 0; n < 2; ++n) _Pragma("unroll") for (int k = 0; k < 2; ++k) dst[n][k] =             \
        *(const LAS bf16x8*)(lds + G_SB(b, h) + boff + n * 2048 + k * 1024);                                            \
  } while (0)
#define G_MMA(ai, bj, At, Bq)                                                                                           \
  do {                                                                                                                  \
    __builtin_amdgcn_s_setprio(1);                                                                                      \
    _Pragma("unroll") for (int m = 0; m < 4; ++m) _Pragma("unroll") for (int n = 0; n < 2; ++n) _Pragma("unroll") for ( \
        int k = 0; k < 2; ++k) acc[ai][bj][m][n] =                                                                      \
        __builtin_amdgcn_mfma_f32_16x16x32_bf16(Bq[n][k], At[m][k], acc[ai][bj][m][n], 0, 0, 0);                        \
    __builtin_amdgcn_s_setprio(0);                                                                                      \
  } while (0)
#define G_WAIT_V(n) asm volatile("s_waitcnt vmcnt(" #n ")" ::: "memory")
#define G_WAIT_L(n) asm volatile("s_waitcnt lgkmcnt(" #n ")" ::: "memory")
#define G_BAR __builtin_amdgcn_s_barrier()
#define G_SCHED __builtin_amdgcn_sched_barrier(0)
  Order S;
  S.init(M, N, offshift);
  Unit cur, nxt;
  int ui = 0;
  if (S.next(0, cur)) {
    f32x4 acc[2][2][4][2];
#pragma unroll
    for (int a = 0; a < 2; ++a)
#pragma unroll
      for (int b = 0; b < 2; ++b)
#pragma unroll
        for (int m = 0; m < 4; ++m)
#pragma unroll
          for (int n = 0; n < 2; ++n) acc[a][b][m][n] = (f32x4){0.f, 0.f, 0.f, 0.f};
    bf16x8 At[4][2], B0[2][2], B1[2][2];
    const char* cA = (const char*)Ag + (size_t)cur.pm * tstep;
    const char* cB = (const char*)Btg + (size_t)cur.pn * tstep;
    float rs_pre[2][4];
#define G_PRELOAD_RS(UU)                                                                                          \
  if constexpr (EPI == EPI_SWIGLU || EPI == EPI_PLEGATE) {                                                        \
    _Pragma("unroll") for (int ai_ = 0; ai_ < 2; ++ai_) _Pragma("unroll") for (int m_ = 0; m_ < 4; ++m_)         \
        rs_pre[ai_][m_] = ea.ss_in[(UU).pm * 256 + wr * 64 + fr + ai_ * 128 + m_ * 16];                           \
  } else {                                                                                                        \
    _Pragma("unroll") for (int ai_ = 0; ai_ < 2; ++ai_) _Pragma("unroll") for (int m_ = 0; m_ < 4; ++m_) rs_pre[ai_][m_] = 0.f; \
  }
    G_PRELOAD_RS(cur);
    G_STAGE(G_SB(0, 0), cB); G_STAGE(G_SA(0, 0), cA); G_STAGE(G_SB(0, 1), cB + hstep); G_STAGE(G_SA(0, 1), cA + hstep);
    if (wr == 1) G_BAR;
    G_WAIT_V(4); G_BAR;
    G_STAGE(G_SB(1, 0), cB + kstep); G_STAGE(G_SA(1, 0), cA + kstep); G_STAGE(G_SB(1, 1), cB + hstep + kstep);
    G_WAIT_V(6); G_BAR;
    for (;;) {
      const bool has_next = S.next(ui + 1, nxt);
      const char* nA = has_next ? (const char*)Ag + (size_t)nxt.pm * tstep : cA;
      const char* nB = has_next ? (const char*)Btg + (size_t)nxt.pn * tstep : cB;
      for (int t = 0; t < nt; t += 2) {
        const bool last = (t == nt - 2);
        const char* a1 = cA + (size_t)(t + 1) * kstep;
        const char* a2 = last ? nA : cA + (size_t)(t + 2) * kstep;
        const char* b2 = last ? nB : cB + (size_t)(t + 2) * kstep;
        const char* a3 = a2 + kstep;
        const char* b3 = b2 + kstep;
        G_LDB(B0, 0, 0); G_SCHED; G_LDA(At, 0, 0); G_STAGE(G_SA(1, 1), a1 + hstep);
        G_WAIT_L(8); G_BAR; G_WAIT_L(0); G_MMA(0, 0, At, B0); G_BAR; G_SCHED;
        G_LDB(B1, 0, 1); G_STAGE(G_SB(0, 0), b2);
        G_BAR; G_WAIT_L(0); G_MMA(0, 1, At, B1); G_BAR;
        G_LDA(At, 0, 1); G_STAGE(G_SA(0, 0), a2);
        G_BAR; G_WAIT_L(0); G_MMA(1, 0, At, B0); G_BAR; G_SCHED;
        G_STAGE(G_SB(0, 1), b2 + hstep);
        G_WAIT_V(6); G_BAR; G_MMA(1, 1, At, B1); G_BAR;
        G_LDB(B0, 1, 0); G_SCHED; G_LDA(At, 1, 0); G_STAGE(G_SA(0, 1), a2 + hstep);
        G_WAIT_L(8); G_BAR; G_WAIT_L(0); G_MMA(0, 0, At, B0); G_BAR; G_SCHED;
        G_LDB(B1, 1, 1); G_STAGE(G_SB(1, 0), b3);
        G_BAR; G_WAIT_L(0); G_MMA(0, 1, At, B1); G_BAR;
        G_LDA(At, 1, 1); G_STAGE(G_SA(1, 0), a3);
        G_BAR; G_WAIT_L(0); G_MMA(1, 0, At, B0); G_BAR; G_SCHED;
        G_STAGE(G_SB(1, 1), b3 + hstep);
        G_WAIT_V(6); G_BAR; G_MMA(1, 1, At, B1); G_BAR;
      }
      gemm_epilogue<EPI>(acc, cur, wr, wc, fr, fq, ea, rs_pre);
      if (!has_next) break;
#pragma unroll
      for (int a = 0; a < 2; ++a)
#pragma unroll
        for (int b = 0; b < 2; ++b)
#pragma unroll
          for (int m = 0; m < 4; ++m)
#pragma unroll
            for (int n = 0; n < 2; ++n) acc[a][b][m][n] = (f32x4){0.f, 0.f, 0.f, 0.f};
      cur = nxt; cA = nA; cB = nB; ++ui;
      G_PRELOAD_RS(cur);
    }
    G_WAIT_V(0);
    if (wr == 0) G_BAR;
    G_BAR;
  }
  __syncthreads();
#undef G_PRELOAD_RS
#undef G_SA
#undef G_SB
#undef G_STAGE
#undef G_LDA
#undef G_LDB
#undef G_MMA
#undef G_WAIT_V
#undef G_WAIT_L
#undef G_BAR
#undef G_SCHED
}

__device__ __forceinline__ f32x16 mfma32(bf16x8 a, bf16x8 b, f32x16 c) {
  return __builtin_amdgcn_mfma_f32_32x32x16_bf16(a, b, c, 0, 0, 0);
}

template <bool FOX>
__device__ __forceinline__ void attn_wave(const u16* __restrict__ Qb, int ldq, const u16* __restrict__ Kb, int ldk,
                                          const u16* __restrict__ Vt, const float* __restrict__ c2n, float sink2, int q0,
                                          u16* __restrict__ Yb, int ldy) {
  const int lane = lane_id_v();
  const int ln = lane & 31, hh = lane >> 5;
  bf16x8 bq[2][4];
#pragma unroll
  for (int qt = 0; qt < 2; ++qt)
#pragma unroll
    for (int kk = 0; kk < 4; ++kk)
      bq[qt][kk] = *reinterpret_cast<const bf16x8*>(Qb + (size_t)(q0 + qt * 32 + ln) * ldq + kk * 16 + hh * 8);
  f32x16 o[2][2];
#pragma unroll
  for (int a = 0; a < 2; ++a)
#pragma unroll
    for (int b = 0; b < 2; ++b)
#pragma unroll
      for (int r = 0; r < 16; ++r) o[a][b][r] = 0.f;
  float mrun[2], lrun[2];
  mrun[0] = mrun[1] = FOX ? -1e30f : sink2;
  lrun[0] = lrun[1] = FOX ? 0.f : (hh == 0 ? 1.f : 0.f);
  const int kt0 = FOX ? 0 : (max(0, q0 - 128) >> 5), kt1 = (q0 + 64) >> 5;
  bf16x8 ak[4];
  f32x16 negc;
  const u16* kp = Kb + (size_t)kt0 * 2048 + lane * 8;
  const u16* vp = Vt + (size_t)kt0 * 2048 + lane * 8;
  const float* cp = c2n + kt0 * 32 + 4 * hh;
#pragma unroll
  for (int kk = 0; kk < 4; ++kk) ak[kk] = *reinterpret_cast<const bf16x8*>(kp + kk * 512);
  if (FOX) {
#pragma unroll
    for (int jj = 0; jj < 4; ++jj) {
      f32x4 cv = *reinterpret_cast<const f32x4*>(cp + 8 * jj);
      negc[4 * jj + 0] = cv[0]; negc[4 * jj + 1] = cv[1]; negc[4 * jj + 2] = cv[2]; negc[4 * jj + 3] = cv[3];
    }
  } else {
#pragma unroll
    for (int r = 0; r < 16; ++r) negc[r] = 0.f;
  }
  for (int kt = kt0; kt < kt1; ++kt) {
    const int k0 = kt * 32;
    bf16x8 av[2][2];
#pragma unroll
    for (int dt = 0; dt < 2; ++dt)
#pragma unroll
      for (int ks = 0; ks < 2; ++ks) av[dt][ks] = *reinterpret_cast<const bf16x8*>(vp + (dt * 2 + ks) * 512);
    f32x16 st[2];
#pragma unroll
    for (int qt = 0; qt < 2; ++qt) {
      st[qt] = mfma32(ak[0], bq[qt][0], negc);
#pragma unroll
      for (int kk = 1; kk < 4; ++kk) st[qt] = mfma32(ak[kk], bq[qt][kk], st[qt]);
    }
    kp += 2048;
    vp += 2048;
    cp += 32;
    if (kt + 1 < kt1) {
#pragma unroll
      for (int kk = 0; kk < 4; ++kk) ak[kk] = *reinterpret_cast<const bf16x8*>(kp + kk * 512);
      if (FOX) {
#pragma unroll
        for (int jj = 0; jj < 4; ++jj) {
          f32x4 cv = *reinterpret_cast<const f32x4*>(cp + 8 * jj);
          negc[4 * jj + 0] = cv[0]; negc[4 * jj + 1] = cv[1]; negc[4 * jj + 2] = cv[2]; negc[4 * jj + 3] = cv[3];
        }
      }
    }
    const bool needmask = FOX ? (k0 + 31 > q0) : true;
    if (needmask) {
#pragma unroll
      for (int qt = 0; qt < 2; ++qt) {
        int qpos = q0 + qt * 32 + ln;
#pragma unroll
        for (int r = 0; r < 16; ++r) {
          int kpos = k0 + 8 * (r >> 2) + 4 * hh + (r & 3);
          bool bad = kpos > qpos;
          if (!FOX) bad = bad || (qpos - kpos >= 128);
          st[qt][r] = bad ? -1e30f : st[qt][r];
        }
      }
    }
    bf16x8 bp[2][2];
#pragma unroll
    for (int qt = 0; qt < 2; ++qt) {
      float mx = fmaxf(fmaxf(st[qt][0], st[qt][1]), fmaxf(st[qt][2], st[qt][3]));
#pragma unroll
      for (int r = 4; r < 16; r += 4) mx = fmaxf(fmaxf(mx, st[qt][r]), fmaxf(fmaxf(st[qt][r + 1], st[qt][r + 2]), st[qt][r + 3]));
      mx = xmax32(mx);
      const float mnew = fmaxf(mrun[qt], mx);
      const float alpha = ex2(mrun[qt] - mnew);
      mrun[qt] = mnew;
      float ps0 = 0.f, ps1 = 0.f;
#pragma unroll
      for (int r = 0; r < 16; r += 2) {
        float p0 = ex2(st[qt][r] - mnew), p1 = ex2(st[qt][r + 1] - mnew);
        ps0 += p0; ps1 += p1;
        st[qt][r] = p0; st[qt][r + 1] = p1;
      }
      lrun[qt] = lrun[qt] * alpha + (ps0 + ps1);
#pragma unroll
      for (int dt = 0; dt < 2; ++dt) o[dt][qt] = o[dt][qt] * alpha;
#pragma unroll
      for (int ks = 0; ks < 2; ++ks) {
        union { bf16x8 v; uint32_t w[4]; } u;
#pragma unroll
        for (int e = 0; e < 4; ++e) u.w[e] = pack2(st[qt][8 * ks + 2 * e], st[qt][8 * ks + 2 * e + 1]);
        bp[qt][ks] = u.v;
      }
    }
#pragma unroll
    for (int dt = 0; dt < 2; ++dt)
#pragma unroll
      for (int qt = 0; qt < 2; ++qt)
#pragma unroll
        for (int ks = 0; ks < 2; ++ks) o[dt][qt] = mfma32(av[dt][ks], bp[qt][ks], o[dt][qt]);
  }
#pragma unroll
  for (int qt = 0; qt < 2; ++qt) {
    float lt = xsum32(lrun[qt]);
    float inv = 1.f / lt;
    u16* yp = Yb + (size_t)(q0 + qt * 32 + ln) * ldy;
#pragma unroll
    for (int dt = 0; dt < 2; ++dt)
#pragma unroll
      for (int jj = 0; jj < 4; ++jj) {
        uint2 pk;
        pk.x = pack2(o[dt][qt][4 * jj + 0] * inv, o[dt][qt][4 * jj + 1] * inv);
        pk.y = pack2(o[dt][qt][4 * jj + 2] * inv, o[dt][qt][4 * jj + 3] * inv);
        *reinterpret_cast<uint2*>(yp + dt * 32 + 8 * jj + 4 * hh) = pk;
      }
  }
}

template <bool FINAL>
__device__ __forceinline__ void lru_job(const Params& P, int j, int b, int chunk, int h, char* ldsw) {
  const int lane = lane_id_v();
  const int ln = lane & 31, hh = lane >> 5;
  const int ch = h * 64 + lane;
  float* rbuf = reinterpret_cast<float*>(ldsw);
  float* ibuf = reinterpret_cast<float*>(ldsw + 8192);
  u16* xcb = reinterpret_cast<u16*>(ldsw + 8192);
  const float* cw = P.in[I_CONVW] + (size_t)j * 4 * 512;
  const float cw0 = cw[ch], cw1 = cw[512 + ch], cw2 = cw[1024 + ch], cw3 = cw[1536 + ch];
  const float cb = P.in[I_CONVB][j * 512 + ch];
  const float ba = P.in[I_BA][j * 512 + ch], bx = P.in[I_BX][j * 512 + ch];
  const float lam = P.in[I_LAM][j * 512 + ch];
  const float sp = fmaxf(lam, 0.f) + log1pf(__expf(-fabsf(lam)));
  const u16* lruw = reinterpret_cast<const u16*>(P.ws + OFF_W_LRU);
  const u16* wat = lruw + (size_t)((j * 2 + 0) * 8 + h) * 4096;
  const u16* wxt = lruw + (size_t)((j * 2 + 1) * 8 + h) * 4096;
  const u16* Z = reinterpret_cast<const u16*>(P.ws + OFF_BIG);
  const u16* xap = Z + (size_t)(b * 4096) * 1536 + ch;
  u16* Y = reinterpret_cast<u16*>(P.ws + OFF_BUFY);
  float* agg = reinterpret_cast<float*>(P.ws + OFF_LRUAGG);
  const int t0 = chunk * 64;
  float w0 = 0.f, w1 = 0.f, w2 = 0.f;
  if (t0 > 0) {
    w0 = bf2f(xap[(size_t)(t0 - 3) * 1536]);
    w1 = bf2f(xap[(size_t)(t0 - 2) * 1536]);
    w2 = bf2f(xap[(size_t)(t0 - 1) * 1536]);
  }
  float v0 = w0, v1 = w1, v2 = w2;
  float hst = 0.f, Ap = 1.f;
  if (FINAL) {
    const float2* ap = reinterpret_cast<const float2*>(agg) + (size_t)(b * 64) * 512 + ch;
    int c = 0;
    for (; c + 8 <= chunk; c += 8) {
      float2 ab[8];
#pragma unroll
      for (int q = 0; q < 8; ++q) ab[q] = ap[(size_t)(c + q) * 512];
#pragma unroll
      for (int q = 0; q < 8; ++q) hst = ab[q].x * hst + ab[q].y;
    }
    for (; c < chunk; ++c) {
      float2 ab = ap[(size_t)c * 512];
      hst = ab.x * hst + ab.y;
    }
  }
  for (int sub = 0; sub < 2; ++sub) {
    const u16* xs = xap + (size_t)(t0 + sub * 32) * 1536;
#pragma unroll 16
    for (int tt = 0; tt < 32; ++tt) {
      float xt = bf2f(xs[(size_t)tt * 1536]);
      float v = cb + w0 * cw0 + w1 * cw1 + w2 * cw2 + xt * cw3;
      xcb[tt * 72 + lane] = f2bf(v);
      w0 = w1; w1 = w2; w2 = xt;
    }
    f32x16 ar0, ar1, ai0, ai1;
#pragma unroll
    for (int nt = 0; nt < 2; ++nt) {
      f32x16 ar, ai;
#pragma unroll
      for (int r = 0; r < 16; ++r) { ar[r] = 0.f; ai[r] = 0.f; }
#pragma unroll
      for (int kk = 0; kk < 4; ++kk) {
        bf16x8 a = *reinterpret_cast<const bf16x8*>(xcb + ln * 72 + kk * 16 + hh * 8);
        bf16x8 ba_ = *reinterpret_cast<const bf16x8*>(wat + (nt * 32 + ln) * 64 + kk * 16 + hh * 8);
        bf16x8 bx_ = *reinterpret_cast<const bf16x8*>(wxt + (nt * 32 + ln) * 64 + kk * 16 + hh * 8);
        ar = mfma32(a, ba_, ar);
        ai = mfma32(a, bx_, ai);
      }
      if (nt == 0) { ar0 = ar; ai0 = ai; } else { ar1 = ar; ai1 = ai; }
    }
#pragma unroll
    for (int r = 0; r < 16; ++r) {
      int trow = 8 * (r >> 2) + 4 * hh + (r & 3);
      rbuf[trow * 64 + ln] = ar0[r];
      rbuf[trow * 64 + 32 + ln] = ar1[r];
      ibuf[trow * 64 + ln] = ai0[r];
      ibuf[trow * 64 + 32 + ln] = ai1[r];
    }
    const size_t rowb = (size_t)b * 4096 + t0 + sub * 32;
    float xq[4], yq[4], xqn[4], yqn[4];
#pragma unroll
    for (int q = 0; q < 4; ++q) {
      xq[q] = bf2f(xs[(size_t)q * 1536]);
      yq[q] = FINAL ? bf2f(Z[(rowb + q) * 1536 + 512 + ch]) : 0.f;
    }
    for (int tg = 0; tg < 32; tg += 4) {
      if (tg + 4 < 32) {
#pragma unroll
        for (int q = 0; q < 4; ++q) {
          xqn[q] = bf2f(xs[(size_t)(tg + 4 + q) * 1536]);
          yqn[q] = FINAL ? bf2f(Z[(rowb + tg + 4 + q) * 1536 + 512 + ch]) : 0.f;
        }
      }
#pragma unroll
      for (int q = 0; q < 4; ++q) {
        const int tt = tg + q;
        const float xt = xq[q];
        float xcv = cb + v0 * cw0 + v1 * cw1 + v2 * cw2 + xt * cw3;
        v0 = v1; v1 = v2; v2 = xt;
        float rr = sigmoidf_(rbuf[tt * 64 + lane] + ba);
        float ii = sigmoidf_(ibuf[tt * 64 + lane] + bx);
        float la = -8.f * rr * sp;
        float a = __expf(la);
        const float x2 = 2.f * la;
        const float om = (x2 > -0.03f) ? -x2 * (1.f + x2 * (0.5f + x2 * (0.16666667f + x2 * 0.041666667f))) : 1.f - a * a;
        float bc = __builtin_amdgcn_sqrtf(om);
        hst = a * hst + bc * ii * xcv;
        if (FINAL) {
          Y[(rowb + tt) * 1024 + ch] = f2bf(hst * gelu_tanh(yq[q]));
        } else {
          Ap *= a;
        }
      }
#pragma unroll
      for (int q = 0; q < 4; ++q) { xq[q] = xqn[q]; yq[q] = yqn[q]; }
    }
  }
  if (!FINAL) {
    *reinterpret_cast<float2*>(agg + ((size_t)(b * 64 + chunk) * 512 + ch) * 2) = make_float2(Ap, hst);
  }
}

template <bool FINAL>
__device__ __forceinline__ void s5_wave(const Params& P, int j, int g, int idx0, int stride, char* ldsw) {
  const int lane = lane_id_v();
  const int p = lane;
  const int jg = j * 32 + g;
  const float lr = P.in[I_S5LRE][jg * 64 + p], li = P.in[I_S5LIM][jg * 64 + p];
  const float dt = expf(P.in[I_S5LOGDT][jg]);
  const float er = expf(lr * dt);
  float sn, cs;
  sincosf(li * dt, &sn, &cs);
  const float lbr = er * cs, lbi = er * sn;
  const float nr = lbr - 1.f, ni = lbi;
  const float den = 1.f / (lr * lr + li * li);
  const float cr = (nr * lr + ni * li) * den, ci = (ni * lr - nr * li) * den;
  typedef float f32x2 __attribute__((ext_vector_type(2)));
  f32x2 bb[16];
  {
    const float4* br4 = reinterpret_cast<const float4*>(P.in[I_S5BRE] + ((size_t)jg * 64 + p) * 16);
    const float4* bi4 = reinterpret_cast<const float4*>(P.in[I_S5BIM] + ((size_t)jg * 64 + p) * 16);
#pragma unroll
    for (int q = 0; q < 4; ++q) {
      float4 a = br4[q], c = bi4[q];
      bb[4 * q + 0] = (f32x2){cr * a.x - ci * c.x, cr * c.x + ci * a.x};
      bb[4 * q + 1] = (f32x2){cr * a.y - ci * c.y, cr * c.y + ci * a.y};
      bb[4 * q + 2] = (f32x2){cr * a.z - ci * c.z, cr * c.z + ci * a.z};
      bb[4 * q + 3] = (f32x2){cr * a.w - ci * c.w, cr * c.w + ci * a.w};
    }
  }
  const u16* Zo = reinterpret_cast<const u16*>(P.ws + OFF_BIG);
  float2* hend = reinterpret_cast<float2*>(P.ws + OFF_S5END);
  uint32_t* hbuf = reinterpret_cast<uint32_t*>(ldsw);
  float pr = lbr, pi = lbi;
#pragma unroll
  for (int s6 = 0; s6 < 6; ++s6) {
    float nr2 = pr * pr - pi * pi, ni2 = 2.f * pr * pi;
    pr = nr2; pi = ni2;
  }
  const int fr = lane & 15, fq = lane >> 4;
  bf16x8 bc[4];
  f32x4 dv4 = {0.f, 0.f, 0.f, 0.f};
  if (FINAL) {
    const float* crp = P.in[I_S5CRE] + ((size_t)jg * 16 + fr) * 64;
    const float* cip = P.in[I_S5CIM] + ((size_t)jg * 16 + fr) * 64;
#pragma unroll
    for (int ks = 0; ks < 4; ++ks) {
      float4 a = *reinterpret_cast<const float4*>(crp + ks * 16 + fq * 4);
      float4 c = *reinterpret_cast<const float4*>(cip + ks * 16 + fq * 4);
      union { bf16x8 v; uint32_t w[4]; } uu_;
      uu_.w[0] = pack2(a.x, -c.x); uu_.w[1] = pack2(a.y, -c.y); uu_.w[2] = pack2(a.z, -c.z); uu_.w[3] = pack2(a.w, -c.w);
      bc[ks] = uu_.v;
    }
    dv4 = *reinterpret_cast<const f32x4*>(P.in[I_S5D] + j * 512 + g * 16 + 4 * fq);
  }
  for (int idx = idx0; idx < 16384; idx += stride) {
  const int b = idx >> 11, chunk = ((idx >> 5) + 8 * b) & 63;
  const size_t rowbase = (size_t)b * 4096 + chunk * 64;
  const u16* up = Zo + (rowbase + lane) * 1280 + 768 + g * 16;
  const uint4 u0 = *reinterpret_cast<const uint4*>(up);
  const uint4 u1 = *reinterpret_cast<const uint4*>(up + 8);
  float hr = 0.f, hi = 0.f;
  if (FINAL) {
    const float2* hp = hend + ((size_t)(b * 64) * 32 + g) * 64 + p;
    int c = 0;
    for (; c + 8 <= chunk; c += 8) {
      float2 e[8];
#pragma unroll
      for (int q = 0; q < 8; ++q) e[q] = hp[(size_t)(c + q) * 2048];
#pragma unroll
      for (int q = 0; q < 8; ++q) {
        float t_r = pr * hr - pi * hi + e[q].x;
        float t_i = pr * hi + pi * hr + e[q].y;
        hr = t_r; hi = t_i;
      }
    }
    for (; c < chunk; ++c) {
      float2 e = hp[(size_t)c * 2048];
      float t_r = pr * hr - pi * hi + e.x;
      float t_i = pr * hi + pi * hr + e.y;
      hr = t_r; hi = t_i;
    }
  }
#pragma unroll 2
  for (int t = 0; t < 64; ++t) {
    uint32_t w[8];
    w[0] = __builtin_amdgcn_readlane(u0.x, t); w[1] = __builtin_amdgcn_readlane(u0.y, t);
    w[2] = __builtin_amdgcn_readlane(u0.z, t); w[3] = __builtin_amdgcn_readlane(u0.w, t);
    w[4] = __builtin_amdgcn_readlane(u1.x, t); w[5] = __builtin_amdgcn_readlane(u1.y, t);
    w[6] = __builtin_amdgcn_readlane(u1.z, t); w[7] = __builtin_amdgcn_readlane(u1.w, t);
    f32x2 acc0 = (f32x2){lbr * hr - lbi * hi, lbr * hi + lbi * hr}, acc1 = (f32x2){0.f, 0.f};
#pragma unroll
    for (int q = 0; q < 8; ++q) {
      float ua = __uint_as_float(w[q] << 16), ub = __uint_as_float(w[q] & 0xffff0000u);
      acc0 = bb[2 * q] * (f32x2){ua, ua} + acc0;
      acc1 = bb[2 * q + 1] * (f32x2){ub, ub} + acc1;
    }
    acc0 = acc0 + acc1;
    hr = acc0.x; hi = acc0.y;
    if (FINAL) hbuf[t * 68 + p] = pack2(hr, hi);
  }
  if (!FINAL) {
    hend[((size_t)(b * 64 + chunk) * 32 + g) * 64 + p] = make_float2(hr, hi);
  } else {
    u16* zs = reinterpret_cast<u16*>(P.ws + OFF_BIG + (size_t)T * 1280 * 2);
    uint2 uw[4];
#pragma unroll
    for (int mt = 0; mt < 4; ++mt)
      uw[mt] = *reinterpret_cast<const uint2*>(Zo + (rowbase + mt * 16 + fr) * 1280 + 768 + g * 16 + 4 * fq);
#pragma unroll
    for (int mt = 0; mt < 4; ++mt) {
      f32x4 y = {0.f, 0.f, 0.f, 0.f};
#pragma unroll
      for (int ks = 0; ks < 4; ++ks) {
        bf16x8 a = *reinterpret_cast<const bf16x8*>(hbuf + (mt * 16 + fr) * 68 + ks * 16 + fq * 4);
        y = __builtin_amdgcn_mfma_f32_16x16x32_bf16(bc[ks], a, y, 0, 0, 0);
      }
      const float uvf[4] = {__uint_as_float(uw[mt].x << 16), __uint_as_float(uw[mt].x & 0xffff0000u),
                            __uint_as_float(uw[mt].y << 16), __uint_as_float(uw[mt].y & 0xffff0000u)};
      f32x4 zo;
#pragma unroll
      for (int i = 0; i < 4; ++i) zo[i] = gelu_tanh(y[i] + dv4[i] * uvf[i]);
      *reinterpret_cast<uint2*>(zs + (rowbase + mt * 16 + fr) * 512 + g * 16 + 4 * fq) = pack4(zo);
    }
  }
  }
}

#define XB_TMO 128
#define XB_XCNT(j) (256 + 64 * (j))
#define XB_XSUB(j) (1280 + 64 * (j))
#define XB_XGEN(j) (2304 + 64 * (j))
#define XB_TOP 3328
#define XB_TOPGEN 3392
#define XCD_BAR_WORDS 3456
#define XB_SPIN_CAP (1u << 20)
__device__ __forceinline__ unsigned xb_ld(unsigned* p) { return __hip_atomic_load(p, __ATOMIC_RELAXED, __HIP_MEMORY_SCOPE_AGENT); }
__device__ __forceinline__ unsigned xb_add(unsigned* p, unsigned v) { return __hip_atomic_fetch_add(p, v, __ATOMIC_RELAXED, __HIP_MEMORY_SCOPE_AGENT); }
__device__ __forceinline__ unsigned xb_xcc_id() { return (unsigned)__builtin_amdgcn_s_getreg((3 << 11) | 20) & 0xFu; }
#define XB_SPIN(cond, bar)                                                  \
  do {                                                                      \
    unsigned _sp = 0;                                                       \
    while (cond) {                                                          \
      __builtin_amdgcn_s_sleep(1);                                          \
      if ((++_sp & 255u) == 0u) {                                           \
        if (xb_ld(&(bar)[XB_TMO])) break;                                   \
        if (_sp > XB_SPIN_CAP) { atomicAdd(&(bar)[XB_TMO], 1u); break; }    \
      }                                                                     \
    }                                                                       \
  } while (0)

__device__ __forceinline__ void xcd_barrier_complete(unsigned* bar, unsigned x, unsigned& nloc, unsigned& nx) {
  const unsigned G = gridDim.x;
  unsigned sum, cnt, mine, sp = 0u;
  for (;;) {
    sum = 0u; cnt = 0u; mine = 0u;
#pragma unroll
    for (unsigned j = 0; j < 16; ++j) {
      const unsigned c = xb_ld(&bar[XB_XCNT(j)]);
      sum += c; cnt += (c > 0u) ? 1u : 0u; mine = (j == x) ? c : mine;
    }
    if (sum == G) break;
    __builtin_amdgcn_s_sleep(1);
    if ((++sp & 255u) == 0u) {
      if (xb_ld(&bar[XB_TMO])) break;
      if (sp > XB_SPIN_CAP) { atomicAdd(&bar[XB_TMO], 1u); break; }
    }
  }
  nloc = mine > 0u ? mine : 1u;
  nx = cnt > 0u ? cnt : 1u;
}

__device__ __forceinline__ void xcd_barrier(unsigned* bar, volatile LAS unsigned* st, bool leader_thread) {
  asm volatile("s_waitcnt vmcnt(0)" ::: "memory");
  __syncthreads();
  if (leader_thread) {
    const unsigned x = xb_xcc_id();
    __builtin_amdgcn_s_waitcnt(0);
    unsigned nloc = st[0], nx = st[1];
    if (nloc == 0u) { xcd_barrier_complete(bar, x, nloc, nx); st[0] = nloc; st[1] = nx; }
    const unsigned old = xb_add(&bar[XB_XSUB(x)], 1u);
    const unsigned gen = old / nloc;
    if (old + 1u == (gen + 1u) * nloc) {
      __builtin_amdgcn_fence(__ATOMIC_RELEASE, "agent");
      asm volatile("s_waitcnt vmcnt(0)" ::: "memory");
      const unsigned og = xb_add(&bar[XB_TOP], 1u);
      const unsigned tg = og / nx;
      if (og + 1u == (tg + 1u) * nx) xb_add(&bar[XB_TOPGEN], 1u);
      else XB_SPIN(xb_ld(&bar[XB_TOPGEN]) == tg, bar);
      __builtin_amdgcn_fence(__ATOMIC_ACQUIRE, "agent");
      xb_add(&bar[XB_XGEN(x)], 1u);
      asm volatile("s_waitcnt vmcnt(0)" ::: "memory");
    } else {
      XB_SPIN(xb_ld(&bar[XB_XGEN(x)]) == gen, bar);
      __builtin_amdgcn_fence(__ATOMIC_ACQUIRE, "agent");
      asm volatile("s_waitcnt vmcnt(0)" ::: "memory");
    }
  }
  __syncthreads();
}

enum { K_G1, K_G2, K_G3, K_M1, K_M2, K_M3, K_G4, K_G5, K_G6, K_G7, K_NUM };
enum { C_P0, C_SWIGLU, C_RESID, C_G3, C_M1, C_M2, C_M3, C_G7 };

template <int CLS>
__device__ __forceinline__ void run_phase(const Params& P, int l, int kind_in, const int wid) {
  int kind = kind_in;
  extern __shared__ __attribute__((aligned(16))) char shm_raw[];
  const int lane = lane_id_v(), tid = wid * 64 + lane;
  const int gw = blockIdx.x * 8 + wid, nw = gridDim.x * 8;
  const int gt = blockIdx.x * 512 + tid, ntot = gridDim.x * 512;
  char* ws = P.ws;
  u16* bufX = reinterpret_cast<u16*>(ws + OFF_BUFX);
  u16* bufY = reinterpret_cast<u16*>(ws + OFF_BUFY);
  u16* pe = reinterpret_cast<u16*>(ws + OFF_PE);
  u16* pbf = reinterpret_cast<u16*>(ws + OFF_PBF);
  u16* big = reinterpret_cast<u16*>(ws + OFF_BIG);
  float* ss = reinterpret_cast<float*>(ws + OFF_SS);
  float* sspe = reinterpret_cast<float*>(ws + OFF_SSPE);
  float* flog = reinterpret_cast<float*>(ws + OFF_FLOG);
  float* c2 = reinterpret_cast<float*>(ws + OFF_C2);
  float2* rope = reinterpret_cast<float2*>(ws + OFF_ROPE);
  char* ldsw = shm_raw + wid * LDS_WAVE;
  const bool dup = (kind & 64) != 0;
  kind &= 63;
  const bool even = (l & 1) == 0;
  const int j = l >> 1;
  EpiArgs ea{};
  (void)dup;
  (void)gw; (void)nw; (void)gt; (void)ntot; (void)lane; (void)bufX; (void)bufY; (void)pe; (void)pbf; (void)big; (void)ss;
  (void)sspe; (void)flog; (void)c2; (void)rope; (void)ldsw; (void)even; (void)j;
  if constexpr (CLS == C_P0) {
  {
    float* tile = reinterpret_cast<float*>(shm_raw);
    for (int g = blockIdx.x; g < TL_TOTAL; g += gridDim.x) {
      const TDesc d = weight_tile_desc(P, g);
      transpose_tile(d, tile, tid);
    }
    {
      u16* lruw = reinterpret_cast<u16*>(ws + OFF_W_LRU);
      for (int e = gt; e < 2 * 2 * 8 * 4096; e += ntot) {
        int i = e & 63, jc = (e >> 6) & 63, h = (e >> 12) & 7, m = (e >> 15) & 1, j = e >> 16;
        const float* src = (m ? P.in[I_WX] : P.in[I_WA]) + ((size_t)(j * 8 + h) * 64 + i) * 64 + jc;
        lruw[e] = f2bf(*src);
      }
    }
    for (int e = gt; e < 4096 * 32; e += ntot) {
      int pos = e >> 5, d = e & 31;
      float inv = powf(10000.f, -(float)d / 32.f);
      float ang = (float)pos * inv;
      float s, c;
      sincosf(ang, &s, &c);
      rope[e] = make_float2(c, s);
    }
    for (int e = gt; e < 20 * T; e += ntot) ss[T + e] = 0.f;
    for (int row = gw; row < T; row += nw) {
      const float4* xr = reinterpret_cast<const float4*>(P.in[I_X] + (size_t)row * 1024);
      float sq = 0.f;
#pragma unroll
      for (int q = 0; q < 2; ++q) {
        const int c8 = q * 64 + lane;
        const float4 v0 = xr[2 * c8], v1 = xr[2 * c8 + 1];
        sq += v0.x * v0.x + v0.y * v0.y + v0.z * v0.z + v0.w * v0.w + v1.x * v1.x + v1.y * v1.y + v1.z * v1.z + v1.w * v1.w;
        uint4 ph, pl;
        ph.x = pack2(v0.x, v0.y); ph.y = pack2(v0.z, v0.w); ph.z = pack2(v1.x, v1.y); ph.w = pack2(v1.z, v1.w);
        pl.x = pack2(v0.x - __uint_as_float(ph.x << 16), v0.y - __uint_as_float(ph.x & 0xffff0000u));
        pl.y = pack2(v0.z - __uint_as_float(ph.y << 16), v0.w - __uint_as_float(ph.y & 0xffff0000u));
        pl.z = pack2(v1.x - __uint_as_float(ph.z << 16), v1.y - __uint_as_float(ph.z & 0xffff0000u));
        pl.w = pack2(v1.z - __uint_as_float(ph.w << 16), v1.w - __uint_as_float(ph.w & 0xffff0000u));
        *reinterpret_cast<uint4*>(bufY + (size_t)row * 1024 + c8 * 8) = ph;
        *reinterpret_cast<uint4*>(reinterpret_cast<u16*>(P.out) + (size_t)row * 1024 + c8 * 8) = pl;
      }
#pragma unroll
      for (int o = 32; o >= 1; o >>= 1) sq += __shfl_xor(sq, o);
      if (lane == 0) ss[row] = sq;
    }
  }
  } else if constexpr (CLS == C_SWIGLU) {
          const bool first = kind == K_G1;
          ea.ss_in = ss + (size_t)(4 * l + (first ? 0 : 2)) * T;
          ea.out_bf = big;
          const u16* Aop = first ? bufY : bufX;
          const u16* W = reinterpret_cast<const u16*>(ws + (first ? OFF_W_F1GU : OFF_W_F2GU) + l * SZ_FFNGU);
          #ifndef NO_G_SWIGLU
          gemm_phase<EPI_SWIGLU>(Aop, W, T, 5632, 1024, ea, wid);
#endif
          } else if constexpr (CLS == C_RESID) {
          const u16* Aop;
          const u16* W;
          int K;
          if (kind == K_G4) {
            Aop = bufY;
            W = reinterpret_cast<const u16*>(ws + (even ? OFF_W_EVOUT : OFF_W_ODOUT) + (size_t)j * 1024 * 1024 * 2);
            K = 1024;
            ea.alpha = 1.f;
            ea.ss_out = ss + (size_t)(4 * l + 2) * T;
          } else {
            Aop = big;
            W = reinterpret_cast<const u16*>(ws + (kind == K_G2 ? OFF_W_F1D : OFF_W_F2D) + l * SZ_FFND);
            K = 2816;
            ea.alpha = 0.5f;
            ea.ss_out = ss + (size_t)(4 * l + (kind == K_G2 ? 1 : 3)) * T;
          }
          {
            u16* LO = reinterpret_cast<u16*>(P.out);
            ea.hi_in = (kind == K_G2) ? bufY : bufX;
            ea.lo_in = LO;
            ea.lo_out = (kind == K_G6 && l == 3) ? bufY : LO;
          }
          ea.xb_out = bufX;
          if (dup) { ea.alpha = 0.f; ea.ss_out = c2; }
#ifndef NO_G_RESID
          gemm_phase<EPI_RESID>(Aop, W, T, 1024, K, ea, wid);
#endif
          if (kind == K_G2 && !dup) {
            const float4* ps = reinterpret_cast<const float4*>(P.in[I_P] + (size_t)l * T * 256);
            for (int e = gt; e < T * 256 / 8; e += ntot) {
              const float4 v0 = ps[2 * e], v1 = ps[2 * e + 1];
              uint4 pk;
              pk.x = pack2(v0.x, v0.y); pk.y = pack2(v0.z, v0.w); pk.z = pack2(v1.x, v1.y); pk.w = pack2(v1.z, v1.w);
              reinterpret_cast<uint4*>(pbf)[e] = pk;
            }
          }
          } else if constexpr (CLS == C_G3) {
          ea.ss_in = ss + (size_t)(4 * l + 1) * T;
          ea.out_bf = big;
          EpiArgs ev{};
          ev.ss_in = ea.ss_in;
          if (even) {
            const u16* W = reinterpret_cast<const u16*>(ws + OFF_W_EVIN + (size_t)j * 2816 * 1024 * 2);
            ea.aux_f0 = P.in[I_FOXQN] + j * 64;
            ea.aux_f1 = P.in[I_FOXKN] + j * 64;
            ea.aux_f2 = P.in[I_FOXBF] + j * 8;
            ea.flog = flog;
            ea.kp = big + (size_t)T * 1536 + (size_t)64 * 64 * 4096;
            ea.nh = 8;
#ifndef NO_G_EVEN
            gemm_phase<EPI_EVEN>(bufX, W, T, 2304, 1024, ea, wid);
#endif
            ev.vt = big + (size_t)T * 1536;
            ev.nh = 8;
#ifndef NO_G_VT
            gemm_phase<EPI_VT>(W + (size_t)2304 * 1024, bufX, 512, T, 1024, ev, wid);
#endif
          } else {
            ea.aux_f0 = P.in[I_SWAQN] + j * 64;
            ea.aux_f1 = P.in[I_SWAKN] + j * 64;
            ea.aux_f2 = reinterpret_cast<const float*>(rope);
            ea.kp = big + (size_t)T * 1792 + (size_t)16 * 64 * 4096;
            ea.nh = 2;
#ifndef NO_G_ODD
            gemm_phase<EPI_ODD>(bufX, reinterpret_cast<const u16*>(ws + OFF_W_ODIN + (size_t)j * 1280 * 1024 * 2), T, 1280,
                                1024, ea, wid);
#endif
            ev.vt = big + (size_t)T * 1792;
            ev.nh = 2;
#ifndef NO_G_VT
            gemm_phase<EPI_VT>(reinterpret_cast<const u16*>(ws + OFF_W_ODV + (size_t)j * 256 * 1024 * 2), bufX, 256, T, 1024, ev, wid, 16);
#endif
          }
          EpiArgs eb{};
          eb.out_bf = pe;
          eb.aux_f1 = P.in[I_PLEN] + l * 1024;
          eb.ss_out = dup ? c2 : sspe + (size_t)l * T;
#ifndef NO_G_PE
          gemm_phase<EPI_PE>(pbf, reinterpret_cast<const u16*>(ws + OFF_W_PLE + (size_t)l * 1024 * 256 * 2), T, 1024, 256, eb, wid, even ? -1 : 0);
#endif
          } else if constexpr (CLS == C_M1) {
          if (even) {
#ifndef NO_LRU
            for (int idx = gw; idx < 4096; idx += nw) lru_job<false>(P, j, idx >> 9, (idx >> 3) & 63, idx & 7, ldsw);
#endif
            if (wid == 0 && blockIdx.x < 64) {
              int bh = blockIdx.x, b = bh >> 3, h = bh & 7;
              const float* fp = flog + ((size_t)b * 4096 + lane * 64) * 8 + h;
              float fv[64];
#pragma unroll
              for (int t = 0; t < 64; ++t) fv[t] = fp[t * 8];
              float s = 0.f;
#pragma unroll
              for (int t = 0; t < 64; ++t) s += fv[t];
              float inc = s;
#pragma unroll
              for (int o = 1; o < 64; o <<= 1) {
                float v = __shfl_up(inc, o);
                if (lane >= o) inc += v;
              }
              float run = inc - s;
              float* cp = c2 + (size_t)bh * 4096 + lane * 64;
#pragma unroll
              for (int t = 0; t < 64; t += 4) {
                f32x4 o4;
#pragma unroll
                for (int q = 0; q < 4; ++q) { run += fv[t + q]; o4[q] = -run * LOG2E; }
                *reinterpret_cast<f32x4*>(cp + t) = o4;
              }
            }
          } else {
            const u16* Zo = big;
            const u16* vto = big + (size_t)T * 1792;
            const u16* kpo = vto + (size_t)16 * 64 * 4096;
            for (int it = blockIdx.x; it < 512; it += gridDim.x) {
              int qblk = it & 7, h = (it >> 3) & 7, b = it >> 6;
              int kvh = h >> 2;
              int q0 = (qblk * 8 + wid) * 64;
              float sink2 = P.in[I_SINKS][j * 8 + h] * LOG2E;
#ifndef NO_ATTN
              attn_wave<false>(Zo + (size_t)b * 4096 * 1280 + h * 64, 1280, kpo + (size_t)(b * 2 + kvh) * 64 * 4096, 0,
                               vto + (size_t)(b * 2 + kvh) * 64 * 4096, c2, sink2, q0,
                               bufY + (size_t)b * 4096 * 1024 + h * 64, 1024);
#endif
            }
#ifndef NO_S5
            if ((nw & 31) == 0) s5_wave<false>(P, j, gw & 31, gw, nw, ldsw);
            else for (int idx = gw; idx < 16384; idx += nw) s5_wave<false>(P, j, idx & 31, idx, 16384, ldsw);
#endif
          }
          } else if constexpr (CLS == C_M2) {
          if (even) {
            const u16* Z = big;
            const u16* vt = big + (size_t)T * 1536;
            const u16* kpe = vt + (size_t)64 * 64 * 4096;
            for (int it = blockIdx.x; it < 512; it += gridDim.x) {
              int bh = it & 63, gsel = it >> 6;
              int G = gsel < 4 ? 7 - gsel : gsel - 4;
              int b = bh >> 3, h = bh & 7;
              int q0 = (G * 8 + (gsel < 4 ? wid : 7 - wid)) * 64;
#ifndef NO_ATTN
              attn_wave<true>(Z + (size_t)b * 4096 * 1536 + 1024 + h * 64, 1536, kpe + (size_t)bh * 64 * 4096, 0,
                              vt + (size_t)bh * 64 * 4096, c2 + (size_t)bh * 4096, 0.f, q0,
                              bufY + (size_t)b * 4096 * 1024 + 512 + h * 64, 1024);
#endif
            }
#ifndef NO_LRU
            for (int idx = gw; idx < 4096; idx += nw) lru_job<true>(P, j, idx >> 9, (((idx >> 3) & 63) + 32 * (idx >> 11)) & 63, idx & 7, ldsw);
#endif
          } else {
#ifndef NO_S5
            if ((nw & 31) == 0) s5_wave<true>(P, j, gw & 31, gw, nw, ldsw);
            else for (int idx = gw; idx < 16384; idx += nw) s5_wave<true>(P, j, idx & 31, idx, 16384, ldsw);
#endif
          }
          } else if constexpr (CLS == C_M3) {
          ea.aux_bf = big + (size_t)T * 1280;
          ea.aux_f0 = P.in[I_GLUB] + j * 512;
          ea.out_bf = bufY;
#ifndef NO_G_GLU
          gemm_phase<EPI_GLU>(big + (size_t)T * 1280, reinterpret_cast<const u16*>(ws + OFF_W_GLU + (size_t)j * 512 * 512 * 2), T,
                              512, 512, ea, wid);
#endif
          } else if constexpr (CLS == C_G7) {
          ea.ss_in = ss + (size_t)(4 * l + 3) * T;
          ea.ss_out = ss + (size_t)(4 * l + 4) * T;
          ea.hi_in = bufX;
          ea.lo_in = (l == 3) ? bufY : reinterpret_cast<const u16*>(P.out);
          ea.lo_out = reinterpret_cast<u16*>(P.out);
          ea.xf32_out = (l == 3) ? P.out : nullptr;
          ea.xb_out = bufY;
          ea.aux_bf = pe;
          ea.aux_f0 = sspe + (size_t)l * T;
          ea.aux_f1 = P.in[I_PLEN] + l * 1024;
#ifndef NO_G_PLEGATE
          gemm_phase<EPI_PLEGATE>(bufX, reinterpret_cast<const u16*>(ws + OFF_W_GATE + (size_t)l * 1024 * 1024 * 2), T, 1024,
                                  1024, ea, wid);
#endif
          }
}

__device__ __forceinline__ void run_kind(const Params& P, int l, int kind, const int wid) {
  switch (kind) {
    case K_G1: case K_G5: run_phase<C_SWIGLU>(P, l, kind, wid); break;
    case K_G2: case K_G4: case K_G6: run_phase<C_RESID>(P, l, kind, wid); break;
    case K_G3: run_phase<C_G3>(P, l, kind, wid); break;
    case K_M1: run_phase<C_M1>(P, l, kind, wid); break;
    case K_M2: run_phase<C_M2>(P, l, kind, wid); break;
    case K_M3: run_phase<C_M3>(P, l, kind, wid); break;
    case K_G7: run_phase<C_G7>(P, l, kind, wid); break;
    default: break;
  }
}

#ifndef PROBE_DUP
#define PROBE_DUP 0
#endif
#ifndef MULTI_LAUNCH
#define MULTI_LAUNCH 0
#endif

#if MULTI_LAUNCH
template <int CLS>
__global__ __launch_bounds__(512) void phase_k(Params P, int l, int kind) {
  const int wid = __builtin_amdgcn_readfirstlane(threadIdx.x >> 6);
  run_phase<CLS>(P, l, kind, wid);
}
#else
__global__ __launch_bounds__(512) void mega(Params P) {
  extern __shared__ __attribute__((aligned(16))) char shm_raw[];
  cg::grid_group grid = cg::this_grid();
  const int wid = __builtin_amdgcn_readfirstlane(threadIdx.x >> 6);
  unsigned* bar = reinterpret_cast<unsigned*>(P.ws + OFF_BAR);
  volatile LAS unsigned* st = (volatile LAS unsigned*)(shm_raw + 139264);
  const bool leader = threadIdx.x == 0;
  if (leader) {
    st[0] = 0u; st[1] = 0u;
    (void)xb_add(&bar[XB_XCNT(xb_xcc_id())], 1u);
  }
  run_phase<C_P0>(P, 0, 0, wid);
  grid.sync();
#if PROBE_DUP == 4
  run_phase<C_P0>(P, 0, 0, wid);
  xcd_barrier(bar, st, wid == 0 && lane_id_v() == 0);
#endif
  for (int l = 0; l < 4; ++l) {
    for (int kind = 0; kind < K_NUM; ++kind) {
      if (kind == K_M3 && (l & 1) == 0) continue;
      run_kind(P, l, kind, wid);
      xcd_barrier(bar, st, wid == 0 && lane_id_v() == 0);
#if PROBE_DUP == 1
      if (kind == K_G1 || kind == K_G5) { run_phase<C_SWIGLU>(P, l, kind, wid); xcd_barrier(bar, st, wid == 0 && lane_id_v() == 0); }
#elif PROBE_DUP == 2
      if (kind == K_M1) { run_phase<C_M1>(P, l, kind, wid); xcd_barrier(bar, st, wid == 0 && lane_id_v() == 0); }
      if (kind == K_M2) { run_phase<C_M2>(P, l, kind, wid); xcd_barrier(bar, st, wid == 0 && lane_id_v() == 0); }
#elif PROBE_DUP == 7
      if (kind == K_G2 || kind == K_G4 || kind == K_G6) { run_phase<C_RESID>(P, l, kind | 64, wid); xcd_barrier(bar, st, wid == 0 && lane_id_v() == 0); }
#elif PROBE_DUP == 9
      if (kind == K_G3) { run_phase<C_G3>(P, l, kind | 64, wid); xcd_barrier(bar, st, wid == 0 && lane_id_v() == 0); }
#elif PROBE_DUP == 5
      if (kind == K_M2 && (l & 1) == 0) { run_phase<C_M2>(P, l, kind, wid); xcd_barrier(bar, st, wid == 0 && lane_id_v() == 0); }
#elif PROBE_DUP == 6
      if (kind == K_M1 && (l & 1) == 1) { run_phase<C_M1>(P, l, kind, wid); xcd_barrier(bar, st, wid == 0 && lane_id_v() == 0); }
      if (kind == K_M2 && (l & 1) == 1) { run_phase<C_M2>(P, l, kind, wid); xcd_barrier(bar, st, wid == 0 && lane_id_v() == 0); }
#endif
    }
  }
}
#endif

extern "C" void kernel_launch(void* const* d_in, const int* in_sizes, int n_in, void* d_out, int out_size, void* d_ws,
                              size_t ws_size, hipStream_t stream) {
  if (ws_size < WS_TOTAL || n_in < N_IN) {
    fprintf(stderr, "kernel_launch: bad config ws=%zu need=%zu n_in=%d\n", ws_size, (size_t)WS_TOTAL, n_in);
    return;
  }
  Params p{};
  for (int i = 0; i < N_IN; ++i) p.in[i] = (const float*)d_in[i];
  p.out = (float*)d_out;
  p.ws = (char*)d_ws;
#if MULTI_LAUNCH
  static bool attr_done = false;
  if (!attr_done) {
    (void)hipFuncSetAttribute((const void*)phase_k<C_P0>, hipFuncAttributeMaxDynamicSharedMemorySize, LDS_BYTES);
    (void)hipFuncSetAttribute((const void*)phase_k<C_SWIGLU>, hipFuncAttributeMaxDynamicSharedMemorySize, LDS_BYTES);
    (void)hipFuncSetAttribute((const void*)phase_k<C_RESID>, hipFuncAttributeMaxDynamicSharedMemorySize, LDS_BYTES);
    (void)hipFuncSetAttribute((const void*)phase_k<C_G3>, hipFuncAttributeMaxDynamicSharedMemorySize, LDS_BYTES);
    (void)hipFuncSetAttribute((const void*)phase_k<C_M1>, hipFuncAttributeMaxDynamicSharedMemorySize, LDS_BYTES);
    (void)hipFuncSetAttribute((const void*)phase_k<C_M2>, hipFuncAttributeMaxDynamicSharedMemorySize, LDS_BYTES);
    (void)hipFuncSetAttribute((const void*)phase_k<C_M3>, hipFuncAttributeMaxDynamicSharedMemorySize, LDS_BYTES);
    (void)hipFuncSetAttribute((const void*)phase_k<C_G7>, hipFuncAttributeMaxDynamicSharedMemorySize, LDS_BYTES);
    attr_done = true;
  }
  const dim3 g(256), b(512);
  phase_k<C_P0><<<g, b, LDS_BYTES, stream>>>(p, 0, 0);
  for (int l = 0; l < 4; ++l) {
    for (int kind = 0; kind < K_NUM; ++kind) {
      if (kind == K_M3 && (l & 1) == 0) continue;
      switch (kind) {
        case K_G1: case K_G5: phase_k<C_SWIGLU><<<g, b, LDS_BYTES, stream>>>(p, l, kind); break;
        case K_G2: case K_G4: case K_G6: phase_k<C_RESID><<<g, b, LDS_BYTES, stream>>>(p, l, kind); break;
        case K_G3: phase_k<C_G3><<<g, b, LDS_BYTES, stream>>>(p, l, kind); break;
        case K_M1: phase_k<C_M1><<<g, b, LDS_BYTES, stream>>>(p, l, kind); break;
        case K_M2: phase_k<C_M2><<<g, b, LDS_BYTES, stream>>>(p, l, kind); break;
        case K_M3: phase_k<C_M3><<<g, b, LDS_BYTES, stream>>>(p, l, kind); break;
        case K_G7: phase_k<C_G7><<<g, b, LDS_BYTES, stream>>>(p, l, kind); break;
        default: break;
      }
    }
  }
#else
  static int grid_blocks = 0;
  if (!grid_blocks) {
    (void)hipFuncSetAttribute((const void*)mega, hipFuncAttributeMaxDynamicSharedMemorySize, LDS_BYTES);
    int dev = 0, cus = 0, per_cu = 0;
    (void)hipGetDevice(&dev);
    (void)hipDeviceGetAttribute(&cus, hipDeviceAttributeMultiprocessorCount, dev);
    (void)hipOccupancyMaxActiveBlocksPerMultiprocessor(&per_cu, mega, 512, LDS_BYTES);
    if (per_cu > 1) per_cu = 1;
    grid_blocks = cus * per_cu;
  }
  if (grid_blocks <= 0) { fprintf(stderr, "kernel_launch: occupancy 0\n"); return; }
  (void)hipMemsetAsync((char*)d_ws + OFF_BAR, 0, 16384, stream);
  void* args[] = {&p};
  hipError_t e = hipLaunchCooperativeKernel((const void*)mega, dim3(grid_blocks), dim3(512), args, LDS_BYTES, stream);
  if (e != hipSuccess) fprintf(stderr, "cooperative launch failed: %s (grid %d)\n", hipGetErrorString(e), grid_blocks);
#endif
}
```
